# Optimizing an MI355X kernel written in HIP

```python
import math
import jax, jax.numpy as jnp
from jax import lax
import numpy as np

D_MODEL = 1024
BATCH = 16
SEQ = 2048
DEPTH = 1

MIX_WIDTH = D_MODEL
DIFF_HEADS = 4
DIFF_HEAD_DIM = 64
DIFF_V_DIM = 2 * DIFF_HEAD_DIM
DIFF_WIDTH = DIFF_HEADS * DIFF_V_DIM
MLA_HEADS = 4
MLA_NOPE_DIM = 64
MLA_ROPE_DIM = 32
MLA_QK_DIM = MLA_NOPE_DIM + MLA_ROPE_DIM
MLA_V_DIM = (MIX_WIDTH - DIFF_WIDTH) // MLA_HEADS
MLA_WIDTH = MLA_HEADS * MLA_V_DIM
MLA_Q_RANK = 384
MLA_KV_RANK = 256
DIFF_QK_COLS = DIFF_HEADS * 2 * DIFF_HEAD_DIM
DIFF_V_COLS = DIFF_WIDTH
IN_SPLITS = (DIFF_QK_COLS,
             2 * DIFF_QK_COLS,
             2 * DIFF_QK_COLS + DIFF_V_COLS,
             2 * DIFF_QK_COLS + DIFF_V_COLS + MLA_Q_RANK,
             2 * DIFF_QK_COLS + DIFF_V_COLS + MLA_Q_RANK + MLA_KV_RANK)
IN_COLS = 2 * DIFF_QK_COLS + DIFF_V_COLS + MLA_Q_RANK + MLA_KV_RANK + MLA_ROPE_DIM
D_FF = 2816
ROPE_THETA = 10000.0
NORM_EPS = 1e-6
Q_BLOCK = 128
N_MOD = 9

kernel_name = "hymba_diffattn_mla_macaron_adaln"


def lambda_init_fn(layer_idx):
    return 0.8 - 0.6 * math.exp(-0.3 * layer_idx)


def rmsnorm(x, g):
    x32 = x.astype(jnp.float32)
    y = x32 * lax.rsqrt(jnp.mean(x32 * x32, axis=-1, keepdims=True) + NORM_EPS)
    return y.astype(x.dtype) * g


def modulate(xn, shift, scale):
    return xn * (1 + scale) + shift


def swiglu(x, w_gate, w_up, w_down):
    return (jax.nn.silu(x @ w_gate) * (x @ w_up)) @ w_down


def rope_tables(positions, dim):
    inv_freq = ROPE_THETA ** (-jnp.arange(0, dim, 2, dtype=jnp.float32) / dim)
    ang = positions.astype(jnp.float32)[..., None] * inv_freq
    return jnp.cos(ang), jnp.sin(ang)


def apply_rope(x, cos, sin):
    shape = cos.shape[:2] + (1,) * (x.ndim - 3) + cos.shape[-1:]
    cos = cos.reshape(shape).astype(x.dtype)
    sin = sin.reshape(shape).astype(x.dtype)
    x1, x2 = jnp.split(x, 2, axis=-1)
    return jnp.concatenate([x1 * cos - x2 * sin, x2 * cos + x1 * sin], axis=-1)


def causal_block_attention(q, k, v, scale, combine):
    S = q.shape[1]
    outs = []
    for i in range(S // Q_BLOCK):
        q0 = i * Q_BLOCK
        kend = q0 + Q_BLOCK
        qb = q[:, q0:kend]
        kb = k[:, :kend]
        vb = v[:, :kend]
        s = jnp.einsum('bqhmd,bkhmd->bhmqk', qb, kb,
                       preferred_element_type=jnp.float32) * scale
        causal = (q0 + jnp.arange(Q_BLOCK))[:, None] >= jnp.arange(kend)[None, :]
        s = jnp.where(causal, s, jnp.finfo(jnp.float32).min)
        p = jax.nn.softmax(s, axis=-1)
        w = combine(p).astype(v.dtype)
        outs.append(jnp.einsum('bhqk,bkhd->bqhd', w, vb))
    return jnp.concatenate(outs, axis=1)


def hybrid_mixer(h, cos_d, sin_d, cos_r, sin_r, layer_idx,
                 w_in, lq1, lk1, lq2, lk2, diff_subln,
                 mla_q_norm, mla_w_uq, mla_kv_norm, mla_w_ukv, mla_out_norm, w_out):
    B, S, _ = h.shape
    proj = h @ w_in
    dq, dk, dv, cq, ckv, kr = jnp.split(proj, IN_SPLITS, axis=-1)

    dq = apply_rope(dq.reshape(B, S, DIFF_HEADS, 2, DIFF_HEAD_DIM), cos_d, sin_d)
    dk = apply_rope(dk.reshape(B, S, DIFF_HEADS, 2, DIFF_HEAD_DIM), cos_d, sin_d)
    dv = dv.reshape(B, S, DIFF_HEADS, DIFF_V_DIM)
    lam_init = lambda_init_fn(layer_idx)
    f32 = jnp.float32
    lam = (jnp.exp(jnp.sum(lq1.astype(f32) * lk1.astype(f32)))
           - jnp.exp(jnp.sum(lq2.astype(f32) * lk2.astype(f32))) + lam_init)
    od = causal_block_attention(dq, dk, dv, DIFF_HEAD_DIM ** -0.5,
                                lambda p: p[:, :, 0] - lam * p[:, :, 1])
    od = rmsnorm(od, diff_subln) * (1 - lam_init)
    od = od.reshape(B, S, DIFF_WIDTH)

    cq = rmsnorm(cq, mla_q_norm)
    q = (cq @ mla_w_uq).reshape(B, S, MLA_HEADS, MLA_QK_DIM)
    q_nope, q_rope = jnp.split(q, [MLA_NOPE_DIM], axis=-1)
    q_rope = apply_rope(q_rope, cos_r, sin_r)
    ckv = rmsnorm(ckv, mla_kv_norm)
    kv = (ckv @ mla_w_ukv).reshape(B, S, MLA_HEADS, MLA_NOPE_DIM + MLA_V_DIM)
    k_nope, mv = jnp.split(kv, [MLA_NOPE_DIM], axis=-1)
    kr = apply_rope(kr, cos_r, sin_r)
    kr = jnp.broadcast_to(kr[:, :, None, :], (B, S, MLA_HEADS, MLA_ROPE_DIM))
    qm = jnp.concatenate([q_nope, q_rope], axis=-1)[:, :, :, None, :]
    km = jnp.concatenate([k_nope, kr], axis=-1)[:, :, :, None, :]
    om = causal_block_attention(qm, km, mv, MLA_QK_DIM ** -0.5, lambda p: p[:, :, 0])
    om = rmsnorm(om.reshape(B, S, MLA_WIDTH), mla_out_norm)

    return jnp.concatenate([od, om], axis=-1) @ w_out


def setup_inputs(seed: int = 0) -> dict:
    key = jax.random.key(seed)
    ks = iter(jax.random.split(key, 40))
    nrm = lambda shape, s: jax.random.normal(next(ks), shape, jnp.float32) * s
    gain = lambda shape: 1.0 + nrm(shape, 0.02)
    D, L = D_MODEL, DEPTH
    offs = jax.random.randint(next(ks), (BATCH, 1), 0, 1024, dtype=jnp.int32)
    positions = offs + jnp.arange(SEQ, dtype=jnp.int32)[None, :]
    return {
        "x": nrm((BATCH, SEQ, D), 1.0),
        "c": nrm((BATCH, D), 1.0),
        "positions": positions,
        "w_ada": nrm((L, D, N_MOD * D), D ** -0.5),
        "b_ada": nrm((L, N_MOD * D), 0.02),
        "ffn1_norm": gain((L, D)),
        "ffn1_w_gate": nrm((L, D, D_FF), D ** -0.5),
        "ffn1_w_up": nrm((L, D, D_FF), D ** -0.5),
        "ffn1_w_down": nrm((L, D_FF, D), D_FF ** -0.5),
        "mix_norm": gain((L, D)),
        "w_in": nrm((L, D, IN_COLS), D ** -0.5),
        "diff_lambda_q1": nrm((L, DIFF_HEAD_DIM), 0.1),
        "diff_lambda_k1": nrm((L, DIFF_HEAD_DIM), 0.1),
        "diff_lambda_q2": nrm((L, DIFF_HEAD_DIM), 0.1),
        "diff_lambda_k2": nrm((L, DIFF_HEAD_DIM), 0.1),
        "diff_subln": gain((L, DIFF_V_DIM)),
        "mla_q_norm": gain((L, MLA_Q_RANK)),
        "mla_w_uq": nrm((L, MLA_Q_RANK, MLA_HEADS * MLA_QK_DIM), MLA_Q_RANK ** -0.5),
        "mla_kv_norm": gain((L, MLA_KV_RANK)),
        "mla_w_ukv": nrm((L, MLA_KV_RANK, MLA_HEADS * (MLA_NOPE_DIM + MLA_V_DIM)), MLA_KV_RANK ** -0.5),
        "mla_out_norm": gain((L, MLA_WIDTH)),
        "w_out": nrm((L, MIX_WIDTH, D), MIX_WIDTH ** -0.5),
        "ffn2_norm": gain((L, D)),
        "ffn2_w_gate": nrm((L, D, D_FF), D ** -0.5),
        "ffn2_w_up": nrm((L, D, D_FF), D ** -0.5),
        "ffn2_w_down": nrm((L, D_FF, D), D_FF ** -0.5),
        "final_norm": gain((D,)),
    }


def reference(x, c, positions, w_ada, b_ada,
              ffn1_norm, ffn1_w_gate, ffn1_w_up, ffn1_w_down,
              mix_norm, w_in, diff_lambda_q1, diff_lambda_k1, diff_lambda_q2, diff_lambda_k2,
              diff_subln, mla_q_norm, mla_w_uq, mla_kv_norm, mla_w_ukv, mla_out_norm, w_out,
              ffn2_norm, ffn2_w_gate, ffn2_w_up, ffn2_w_down, final_norm):
    B, S, D = x.shape
    cos_d, sin_d = rope_tables(positions, DIFF_HEAD_DIM)
    cos_r, sin_r = rope_tables(positions, MLA_ROPE_DIM)
    c_act = jax.nn.silu(c)
    h = x
    for l in range(DEPTH):
        mod = (c_act @ w_ada[l] + b_ada[l]).reshape(B, N_MOD, D)[:, :, None, :]
        sh1, sc1, g1, sh2, sc2, g2, sh3, sc3, g3 = [mod[:, j] for j in range(N_MOD)]
        u = modulate(rmsnorm(h, ffn1_norm[l]), sh1, sc1)
        h = h + 0.5 * g1 * swiglu(u, ffn1_w_gate[l], ffn1_w_up[l], ffn1_w_down[l])
        u = modulate(rmsnorm(h, mix_norm[l]), sh2, sc2)
        h = h + g2 * hybrid_mixer(u, cos_d, sin_d, cos_r, sin_r, l,
                                  w_in[l], diff_lambda_q1[l], diff_lambda_k1[l],
                                  diff_lambda_q2[l], diff_lambda_k2[l], diff_subln[l],
                                  mla_q_norm[l], mla_w_uq[l], mla_kv_norm[l], mla_w_ukv[l],
                                  mla_out_norm[l], w_out[l])
        u = modulate(rmsnorm(h, ffn2_norm[l]), sh3, sc3)
        h = h + 0.5 * g3 * swiglu(u, ffn2_w_gate[l], ffn2_w_up[l], ffn2_w_down[l])
    return rmsnorm(h, final_norm)
```

```cpp
#include <hip/hip_runtime.h>
#include <hip/hip_cooperative_groups.h>
#include <cstdio>
#include <cstdint>
namespace cg = cooperative_groups;
namespace pg8 {
#define PG8_LAS __attribute__((address_space(3)))
typedef unsigned short bf16_t;
typedef short bf16x8 __attribute__((ext_vector_type(8)));
typedef float f32x4 __attribute__((ext_vector_type(4)));
typedef unsigned u32x4 __attribute__((ext_vector_type(4)));
constexpr int BM = 256, BK = 64, HALF = 128, HTB = HALF * BK * 2  , STAGE_BYTES = 8 * HTB, NXCD = 8, WGM = 8;

__host__ __device__ __forceinline__ int lds_byte(int r, int c) { const int st = (r >> 4) * 2 + (c >> 5), rr = r & 15, cc = c & 31, ob = rr * 64 + cc * 2; return st * 1024 + (ob ^ (((ob >> 9) & 1) << 5)); }
__host__ __device__ __forceinline__ void stage_rc(int b, int& R, int& C) { const int st = b / 1024, sb = b % 1024, swz = sb ^ (((sb >> 9) & 1) << 5); R = (st >> 1) * 16 + swz / 64; C = (st & 1) * 32 + (swz % 64) / 2; }
__host__ __device__ __forceinline__ int perm32(int rho) { const int n = rho >> 4, i = rho & 15; return 8 * (i >> 2) + 4 * n + (i & 3); }

struct Unit { int pm, pn; };
struct Gemm { const bf16_t* A; const bf16_t* Bt; int M, N, K; };

struct StaticOrder {
    int nM, nN, nwg, G, c;
    __host__ __device__ void init(int M, int N, int G_, int c_) { nM = M / BM; nN = N / BM; nwg = nM * nN; G = G_; c = c_; }
    __host__ __device__ bool next(int i, Unit& u) const {
        const long L = (long)i * G + c; if (L >= nwg) return false;
        int wgid = (int)L; { const int q = nwg / NXCD, r = nwg % NXCD, xcd = wgid % NXCD, off = wgid / NXCD; wgid = (xcd < r ? xcd * (q + 1) : r * (q + 1) + (xcd - r) * q) + off; }
        const int nig = WGM * nN, gid = wgid / nig, fm = gid * WGM, gsz = (nM - fm) < WGM ? (nM - fm) : WGM;
        u.pm = fm + ((wgid % nig) % gsz); u.pn = (wgid % nig) / gsz; return true;
    }
    __device__ __forceinline__ void a_ready(const Unit&) const {}
    __device__ __forceinline__ void done(const Unit&) const {}
};

__device__ __forceinline__ unsigned cvt_pk_bf16(float lo, float hi) { unsigned r; asm volatile("v_cvt_pk_bf16_f32 %0, %1, %2" : "=v"(r) : "v"(lo), "v"(hi)); return r; }
typedef float f32x2 __attribute__((ext_vector_type(2)));
template <class Epi, class Sched, bool ALIGN_EPI = false, bool SP2 = false>
__device__ __forceinline__ void gemm_phase(PG8_LAS unsigned char* lds, const Gemm g, const Sched& S, const Epi& E, const int tid_in) {
    int tid_ = tid_in; asm volatile("" : "+v"(tid_)); const int tid = tid_, wid = __builtin_amdgcn_readfirstlane(tid >> 6), lane = tid & 63, wr = wid >> 2, wc = wid & 3, fr = lane & 15, fq = lane >> 4;
    const int K = g.K, nt = K / BK;
    unsigned voffA[2], voffB[2];
#pragma unroll
    for (int i = 0; i < 2; ++i) { int R, C; stage_rc(tid * 16 + i * 8192, R, C); const int Rb = Epi::PERM ? ((R & ~31) + perm32(R & 31)) : R;
        voffA[i] = (unsigned)(R * K + C) * 2u; voffB[i] = (unsigned)(Rb * K + C) * 2u; }
    const size_t kstep = (size_t)(BK * 2);
    const size_t hstep = (size_t)HALF * K * 2;
    const size_t tstep = 2 * hstep;
    const unsigned ldsw = (unsigned)wid * 1024u;
    const int aoff = lds_byte(wr * 64 + fr, fq * 8), boff = lds_byte(wc * 32 + fr, fq * 8);
#define PG8_SA(b, h) (((b) * 2 + (h)) * HTB)
#define PG8_SB(b, h) ((4 + (b) * 2 + (h)) * HTB)
#define PG8_STAGE(bufoff, gbase, voff) do { _Pragma("unroll") for (int _i = 0; _i < 2; ++_i) \
        __builtin_amdgcn_global_load_lds((const unsigned*)((const char*)(gbase) + (voff)[_i]), (PG8_LAS unsigned*)(lds + (bufoff) + ldsw + _i * 8192), 16, 0, 0); } while (0)
#define PG8_LDA(dst, b, h) do { _Pragma("unroll") for (int m = 0; m < 4; ++m) _Pragma("unroll") for (int k = 0; k < 2; ++k) dst[m][k] = *(const PG8_LAS bf16x8*)(lds + PG8_SA(b, h) + aoff + m * 2048 + k * 1024); } while (0)
#define PG8_LDB(dst, b, h) do { _Pragma("unroll") for (int n = 0; n < 2; ++n) _Pragma("unroll") for (int k = 0; k < 2; ++k) dst[n][k] = *(const PG8_LAS bf16x8*)(lds + PG8_SB(b, h) + boff + n * 2048 + k * 1024); } while (0)
#define PG8_MMA(ai, bj, At, Bt) do { __builtin_amdgcn_s_setprio(1); _Pragma("unroll") for (int m = 0; m < 4; ++m) _Pragma("unroll") for (int n = 0; n < 2; ++n) _Pragma("unroll") for (int k = 0; k < 2; ++k) \
        acc[ai][bj][m][n] = __builtin_amdgcn_mfma_f32_16x16x32_bf16(Bt[n][k], At[m][k], acc[ai][bj][m][n], 0, 0, 0); __builtin_amdgcn_s_setprio(0); } while (0)
#define PG8_WAIT_V(n) asm volatile("s_waitcnt vmcnt(" #n ")" ::: "memory")
#define PG8_WAIT_L(n) asm volatile("s_waitcnt lgkmcnt(" #n ")" ::: "memory")
#define PG8_BAR __builtin_amdgcn_s_barrier()
#define PG8_SCHED __builtin_amdgcn_sched_barrier(0)
    Unit cur, nxt; int ui = 0;
    if (!S.next(0, cur)) return;
    f32x4 acc[2][2][4][2];
#pragma unroll
    for (int a = 0; a < 2; ++a)
#pragma unroll
        for (int b = 0; b < 2; ++b)
#pragma unroll
            for (int m = 0; m < 4; ++m)
#pragma unroll
                for (int n = 0; n < 2; ++n) acc[a][b][m][n] = (f32x4){0.f, 0.f, 0.f, 0.f};
    bf16x8 At[4][2], B0[2][2], B1[2][2];
    const char* cA = (const char*)g.A + (size_t)cur.pm * tstep; const char* cB = (const char*)g.Bt + (size_t)cur.pn * tstep;
    S.a_ready(cur);
    if constexpr (SP2) {
        PG8_STAGE(PG8_SB(0, 0), cB, voffB); PG8_STAGE(PG8_SB(0, 1), cB + hstep, voffB); PG8_STAGE(PG8_SA(0, 0), cA, voffA); PG8_STAGE(PG8_SA(0, 1), cA + hstep, voffA);
        if (wr == 1) PG8_BAR;
        PG8_WAIT_V(2); PG8_BAR;
        PG8_STAGE(PG8_SB(1, 0), cB + kstep, voffB); PG8_STAGE(PG8_SA(1, 0), cA + kstep, voffA); PG8_STAGE(PG8_SB(1, 1), cB + hstep + kstep, voffB);
        PG8_WAIT_V(6); PG8_BAR;
    } else {
        PG8_STAGE(PG8_SB(0, 0), cB, voffB); PG8_STAGE(PG8_SA(0, 0), cA, voffA); PG8_STAGE(PG8_SB(0, 1), cB + hstep, voffB); PG8_STAGE(PG8_SA(0, 1), cA + hstep, voffA);
        if (wr == 1) PG8_BAR;
        PG8_WAIT_V(4); PG8_BAR;
        PG8_STAGE(PG8_SB(1, 0), cB + kstep, voffB); PG8_STAGE(PG8_SA(1, 0), cA + kstep, voffA); PG8_STAGE(PG8_SB(1, 1), cB + hstep + kstep, voffB);
        PG8_WAIT_V(6); PG8_BAR;
    }
    for (;;) {
        const bool has_next = S.next(ui + 1, nxt);
        const char* nA = has_next ? (const char*)g.A + (size_t)nxt.pm * tstep : cA; const char* nB = has_next ? (const char*)g.Bt + (size_t)nxt.pn * tstep : cB;
        _Pragma("nounroll") for (int t = 0; t < nt; t += 2) {
            if constexpr (Epi::MIDK) { if (t == 8) E.midk(acc, cur, wr, fr); }
            const bool last = (t == nt - 2);
            const char* a1 = cA + (size_t)(t + 1) * kstep;
            const char* a2 = last ? nA : cA + (size_t)(t + 2) * kstep; const char* b2 = last ? nB : cB + (size_t)(t + 2) * kstep;
            const char* a3 = a2 + kstep; const char* b3 = b2 + kstep;
            if (last && has_next) S.a_ready(nxt);
            if constexpr (SP2) {
            PG8_LDB(B0, 0, 0); PG8_LDB(B1, 0, 1); PG8_SCHED; PG8_LDA(At, 0, 0); PG8_STAGE(PG8_SA(1, 1), a1 + hstep, voffA);
            PG8_WAIT_V(8); PG8_WAIT_L(0); PG8_BAR; PG8_MMA(0, 0, At, B0); PG8_MMA(0, 1, At, B1); PG8_BAR; PG8_SCHED;
            PG8_LDA(At, 0, 1); PG8_STAGE(PG8_SB(0, 0), b2, voffB); PG8_STAGE(PG8_SB(0, 1), b2 + hstep, voffB); PG8_STAGE(PG8_SA(0, 0), a2, voffA);
            PG8_WAIT_V(8); PG8_WAIT_L(0); PG8_BAR; PG8_MMA(1, 0, At, B0); PG8_MMA(1, 1, At, B1); PG8_BAR; PG8_SCHED;
            PG8_LDB(B0, 1, 0); PG8_LDB(B1, 1, 1); PG8_SCHED; PG8_LDA(At, 1, 0); PG8_STAGE(PG8_SA(0, 1), a2 + hstep, voffA);
            PG8_WAIT_V(8); PG8_WAIT_L(0); PG8_BAR; PG8_MMA(0, 0, At, B0); PG8_MMA(0, 1, At, B1); PG8_BAR; PG8_SCHED;
            PG8_LDA(At, 1, 1); PG8_STAGE(PG8_SB(1, 0), b3, voffB); PG8_STAGE(PG8_SB(1, 1), b3 + hstep, voffB); PG8_STAGE(PG8_SA(1, 0), a3, voffA);
            PG8_WAIT_V(8); PG8_WAIT_L(0); PG8_BAR; PG8_MMA(1, 0, At, B0); PG8_MMA(1, 1, At, B1); PG8_BAR; PG8_SCHED;
            } else {
            PG8_LDB(B0, 0, 0); PG8_SCHED; PG8_LDA(At, 0, 0); PG8_STAGE(PG8_SA(1, 1), a1 + hstep, voffA);
            PG8_WAIT_L(8); PG8_BAR; PG8_WAIT_L(0); PG8_MMA(0, 0, At, B0); PG8_BAR; PG8_SCHED;
            PG8_LDB(B1, 0, 1); PG8_STAGE(PG8_SB(0, 0), b2, voffB);
            PG8_BAR; PG8_WAIT_L(0); PG8_MMA(0, 1, At, B1); PG8_BAR;
            PG8_LDA(At, 0, 1); PG8_STAGE(PG8_SA(0, 0), a2, voffA);
            PG8_BAR; PG8_WAIT_L(0); PG8_MMA(1, 0, At, B0); PG8_BAR; PG8_SCHED;
            PG8_STAGE(PG8_SB(0, 1), b2 + hstep, voffB);
            PG8_WAIT_V(6); PG8_BAR; PG8_MMA(1, 1, At, B1); PG8_BAR;
            PG8_LDB(B0, 1, 0); PG8_SCHED; PG8_LDA(At, 1, 0); PG8_STAGE(PG8_SA(0, 1), a2 + hstep, voffA);
            PG8_WAIT_L(8); PG8_BAR; PG8_WAIT_L(0); PG8_MMA(0, 0, At, B0); PG8_BAR; PG8_SCHED;
            PG8_LDB(B1, 1, 1); PG8_STAGE(PG8_SB(1, 0), b3, voffB);
            PG8_BAR; PG8_WAIT_L(0); PG8_MMA(0, 1, At, B1); PG8_BAR;
            PG8_LDA(At, 1, 1); PG8_STAGE(PG8_SA(1, 0), a3, voffA);
            PG8_BAR; PG8_WAIT_L(0); PG8_MMA(1, 0, At, B0); PG8_BAR; PG8_SCHED;
            PG8_STAGE(PG8_SB(1, 1), b3 + hstep, voffB);
            PG8_WAIT_V(6); PG8_BAR; PG8_MMA(1, 1, At, B1); PG8_BAR;
            }
        }
        if constexpr (ALIGN_EPI) { if (wr == 0) PG8_BAR; }
        if constexpr (!Epi::AFTER_DRAIN) { E(acc, cur, wr, wc, fr, fq); S.done(cur); }
        if (!has_next) break;
#pragma unroll
        for (int a = 0; a < 2; ++a)
#pragma unroll
            for (int b = 0; b < 2; ++b)
#pragma unroll
                for (int m = 0; m < 4; ++m)
#pragma unroll
                    for (int n = 0; n < 2; ++n) acc[a][b][m][n] = (f32x4){0.f, 0.f, 0.f, 0.f};
        cur = nxt; cA = nA; cB = nB; ++ui;
        if constexpr (ALIGN_EPI) { if (wr == 1) PG8_BAR; }
    }
    PG8_WAIT_V(0);
    if constexpr (!ALIGN_EPI) { if (wr == 0) PG8_BAR; }
    PG8_BAR;
    if constexpr (Epi::AFTER_DRAIN) { E.fused(acc, cur, wr, wc, fr, fq, lds, wid, lane); S.done(cur); }
#undef PG8_SA
#undef PG8_SB
#undef PG8_STAGE
#undef PG8_LDA
#undef PG8_LDB
#undef PG8_MMA
#undef PG8_WAIT_V
#undef PG8_WAIT_L
#undef PG8_BAR
#undef PG8_SCHED
}
}

#ifndef REP_ATT
#define REP_ATT 1
#endif
#ifndef REP_P2
#define REP_P2 1
#endif
#ifndef REP_P1
#define REP_P1 1
#endif
#ifndef REP_P3
#define REP_P3 1
#endif
#ifndef REP_P5
#define REP_P5 1
#endif
#ifndef REP_P0
#define REP_P0 1
#endif
#ifndef GEMM_SP2
#define GEMM_SP2 true
#endif
#ifndef REP_P6
#define REP_P6 1
#endif
#ifndef EXTRA_SYNC
#define EXTRA_SYNC 0
#endif
constexpr int BATCH = 16, SEQ = 2048, DM = 1024, M = BATCH * SEQ, DFF = 2816, NMOD = 9 * DM;
constexpr float NORM_EPS = 1e-6f;
constexpr float LOG2E = 1.4426950408889634f;
constexpr float QSC_DIFF = 0.125f * LOG2E;
constexpr float QSC_MLA = 0.10206207261596577f * LOG2E;

constexpr size_t MiB = 1u << 20;
constexpr size_t WS_CTL = 0, WS_LAM = 4096, WS_MODF = 1 * MiB, WS_COSD = 2 * MiB, WS_SIND = 6 * MiB, WS_COSR = 10 * MiB, WS_SINR = 12 * MiB;
constexpr size_t WS_SSCQ = 14 * MiB, WS_SSCKV = 15 * MiB, WS_SSOM = 15 * MiB + 512 * 1024;
constexpr size_t WS_WGU1 = 16 * MiB, WS_WD1 = 27 * MiB, WS_WGU2 = 33 * MiB, WS_WD2 = 44 * MiB, WS_WIN = 50 * MiB, WS_WOUT = 55 * MiB, WS_WUQ = 57 * MiB, WS_WUKV = 58 * MiB;
constexpr size_t WS_U = 64 * MiB, WS_HID = 128 * MiB;
constexpr size_t WS_DQ = 128 * MiB, WS_DK = 160 * MiB, WS_DV = 192 * MiB, WS_CQ = 224 * MiB, WS_CKV = 248 * MiB, WS_KR = 264 * MiB, WS_MQ = 266 * MiB, WS_MK = 290 * MiB, WS_MV = 306 * MiB;
constexpr size_t WS_CV1 = 61 * MiB, WS_CV2 = 62 * MiB, WS_U3 = 338 * MiB, WS_HB = 402 * MiB, WS_END = 466 * MiB, WS_XBUF = 59 * MiB, WS_PCNT = 65536;
static_assert(WS_HID + (size_t)M * DFF * 2 <= WS_END && WS_MV + (size_t)M * 512 * 2 <= WS_END, "ws map");


__device__ __forceinline__ int lane_id() { int l; asm volatile("v_mbcnt_lo_u32_b32 %0, -1, 0\n\tv_mbcnt_hi_u32_b32 %0, -1, %0" : "=v"(l)); return l; }
namespace pg8 {
typedef unsigned u32x2 __attribute__((ext_vector_type(2)));
__device__ __forceinline__ u32x4 pack8(const f32x4 a, const f32x4 b) { u32x4 w; w.x = cvt_pk_bf16(a[0], a[1]); w.y = cvt_pk_bf16(a[2], a[3]); w.z = cvt_pk_bf16(b[0], b[1]); w.w = cvt_pk_bf16(b[2], b[3]); return w; }
__device__ __forceinline__ u32x2 pack4(const f32x4 a) { u32x2 w; w.x = cvt_pk_bf16(a[0], a[1]); w.y = cvt_pk_bf16(a[2], a[3]); return w; }
__device__ __forceinline__ float silu_f(float g) { return g * __builtin_amdgcn_rcpf(1.f + __builtin_amdgcn_exp2f(-LOG2E * g)); }
__device__ __forceinline__ float sumsq4(const f32x4 a) { return (a[0] * a[0] + a[1] * a[1]) + (a[2] * a[2] + a[3] * a[3]); }

__device__ __forceinline__ void deferred_norm_fixup(f32x4 (&acc)[2][2][4][2], const Unit& u, int wr, int wc, int fr, int fq, const float* ssh, const float* cv, int ncols) {
    const int row0 = u.pm * BM + wr * 64 + fr;
    const float* cb = cv + (size_t)(u.pm >> 3) * ncols + u.pn * BM + wc * 32 + 8 * fq;
    f32x4 c[2][2], st[2][4];
#pragma unroll
    for (int bj = 0; bj < 2; ++bj)
#pragma unroll
        for (int n = 0; n < 2; ++n) c[bj][n] = *(const f32x4*)(cb + bj * HALF + n * 4);
#pragma unroll
    for (int ai = 0; ai < 2; ++ai)
#pragma unroll
        for (int m = 0; m < 4; ++m) st[ai][m] = *(const f32x4*)(ssh + (size_t)(row0 + ai * HALF + m * 16) * 4);
#pragma unroll
    for (int ai = 0; ai < 2; ++ai)
#pragma unroll
        for (int m = 0; m < 4; ++m) {
            const float r = __builtin_amdgcn_rsqf(((st[ai][m][0] + st[ai][m][1]) + (st[ai][m][2] + st[ai][m][3])) * (1.f / DM) + NORM_EPS);
#pragma unroll
            for (int bj = 0; bj < 2; ++bj)
#pragma unroll
                for (int n = 0; n < 2; ++n) acc[ai][bj][m][n] = acc[ai][bj][m][n] * r + c[bj][n];
        }
}
template <bool DEFER> struct EpiSwiGLU {
    static constexpr bool PERM = true, AFTER_DRAIN = false, MIDK = false;
    bf16_t* O; int ldc; const float* ssh; const float* cv;
    __device__ __forceinline__ void operator()(f32x4 (&acc)[2][2][4][2], const Unit& u, int wr, int wc, int fr, int fq) const {
        if (DEFER) deferred_norm_fixup(acc, u, wr, wc, fr, fq, ssh, cv, 2 * DFF);
        const int row0 = u.pm * BM + wr * 64 + fr, col0 = u.pn * HALF + wc * 32 + 8 * fq;
#pragma unroll
        for (int ai = 0; ai < 2; ++ai)
#pragma unroll
            for (int m = 0; m < 4; ++m) {
                bf16_t* rowp = O + (size_t)(row0 + ai * HALF + m * 16) * ldc + col0;
                f32x4 h0, h1;
#pragma unroll
                for (int i = 0; i < 4; ++i) { h0[i] = silu_f(acc[ai][0][m][0][i]) * acc[ai][1][m][0][i]; h1[i] = silu_f(acc[ai][0][m][1][i]) * acc[ai][1][m][1][i]; }
                *(u32x4*)rowp = pack8(h0, h1);
            }
    }
};
struct EpiResid {
    static constexpr bool PERM = false, AFTER_DRAIN = false, MIDK = false;
    const float* base; float* out; const float* gate;
    __device__ __forceinline__ void operator()(const f32x4 (&acc)[2][2][4][2], const Unit& u, int wr, int wc, int fr, int fq) const {
        const int row0 = u.pm * BM + wr * 64 + fr, col0 = u.pn * BM + wc * 32 + 4 * fq;
        const float* gv = gate + (size_t)(u.pm >> 3) * NMOD + col0;
        f32x4 g[2][2];
#pragma unroll
        for (int bj = 0; bj < 2; ++bj)
#pragma unroll
            for (int n = 0; n < 2; ++n) g[bj][n] = *(const f32x4*)(gv + bj * HALF + n * 16);
#pragma unroll
        for (int ai = 0; ai < 2; ++ai)
#pragma unroll
            for (int m = 0; m < 4; ++m) {
                const size_t off = (size_t)(row0 + ai * HALF + m * 16) * DM + col0;
#pragma unroll
                for (int bj = 0; bj < 2; ++bj)
#pragma unroll
                    for (int n = 0; n < 2; ++n) { const f32x4 b = *(const f32x4*)(base + off + bj * HALF + n * 16); *(f32x4*)(out + off + bj * HALF + n * 16) = b + g[bj][n] * acc[ai][bj][m][n]; }
            }
    }
};
template <int FINAL, int BASE_BF16, int OUT_BF16, bool MIDK_ = false> struct EpiResidNorm {
    static constexpr bool PERM = true, AFTER_DRAIN = false, MIDK = MIDK_;
    const void* base_; void* out_; const float* modf; int gslot, sslot; bf16_t* U; const float* fn; float* xbuf; unsigned* cnt; unsigned want; PG8_LAS unsigned char* ldsx; const float* ssq;
    __device__ __forceinline__ void midk(f32x4 (&acc)[2][2][4][2], const Unit& u, int wr, int fr) const {
#pragma unroll
        for (int ai = 0; ai < 2; ++ai)
#pragma unroll
            for (int m = 0; m < 4; ++m) { const f32x4 s4 = *(const f32x4*)(ssq + (size_t)(u.pm * BM + ai * HALF + wr * 64 + m * 16 + fr) * 4);
                const float r = __builtin_amdgcn_rsqf(((s4[0] + s4[1]) + (s4[2] + s4[3])) * (1.f / 512.f) + NORM_EPS);
#pragma unroll
                for (int bj = 0; bj < 2; ++bj)
#pragma unroll
                    for (int n = 0; n < 2; ++n) acc[ai][bj][m][n] = acc[ai][bj][m][n] * r; }
    }
    __device__ __forceinline__ void operator()(f32x4 (&acc)[2][2][4][2], const Unit& u, int wr, int wc, int fr, int fq) const {
        const int row0 = u.pm * BM + wr * 64 + fr, col0 = u.pn * BM + wc * 32 + 8 * fq, rt0 = wr * 64 + fr;
        const float* mb = modf + (size_t)(u.pm >> 3) * NMOD + col0;
        if (!FINAL) {
            f32x4 g[2][2], av[2][2];
#pragma unroll
            for (int bj = 0; bj < 2; ++bj)
#pragma unroll
                for (int n = 0; n < 2; ++n) { g[bj][n] = *(const f32x4*)(mb + gslot * DM + bj * HALF + n * 4); av[bj][n] = *(const f32x4*)(mb + (sslot + 1) * DM + bj * HALF + n * 4); }
#pragma unroll
            for (int ai = 0; ai < 2; ++ai)
#pragma unroll
                for (int m = 0; m < 4; ++m) { const size_t off = (size_t)(row0 + ai * HALF + m * 16) * DM + col0; float ss = 0.f;
#pragma unroll
                    for (int bj = 0; bj < 2; ++bj) { f32x4 b0, b1;
                        if (BASE_BF16) { const u32x4 w = *(const u32x4*)((const bf16_t*)base_ + off + bj * HALF);
                            b0 = (f32x4){__uint_as_float(w.x << 16), __uint_as_float(w.x & 0xffff0000u), __uint_as_float(w.y << 16), __uint_as_float(w.y & 0xffff0000u)};
                            b1 = (f32x4){__uint_as_float(w.z << 16), __uint_as_float(w.z & 0xffff0000u), __uint_as_float(w.w << 16), __uint_as_float(w.w & 0xffff0000u)}; }
                        else { b0 = *(const f32x4*)((const float*)base_ + off + bj * HALF); b1 = *(const f32x4*)((const float*)base_ + off + bj * HALF + 4); }
                        const f32x4 h0 = b0 + g[bj][0] * acc[ai][bj][m][0], h1 = b1 + g[bj][1] * acc[ai][bj][m][1];
                        ss += sumsq4(h0) + sumsq4(h1);
                        *(u32x4*)((bf16_t*)out_ + off + bj * HALF) = pack8(h0, h1);
                        *(u32x4*)(U + off + bj * HALF) = pack8(h0 * av[bj][0], h1 * av[bj][1]); }
                    ss += __shfl_xor(ss, 16); ss += __shfl_xor(ss, 32);
                    if (fq == 0) ((PG8_LAS float*)ldsx)[(rt0 + ai * HALF + m * 16) * 4 + wc] = ss;
                    if (m & 1) asm volatile("" ::: "memory"); }
            asm volatile("s_waitcnt lgkmcnt(0)" ::: "memory"); __builtin_amdgcn_s_barrier(); asm volatile("" ::: "memory");
            { const int lane_ = lane_id(), wid_ = wr * 4 + wc, prow_ = wid_ * 32 + (lane_ & 31);
              if (lane_ < 32) { const f32x4 p4 = *(const PG8_LAS f32x4*)((PG8_LAS float*)ldsx + prow_ * 4); xbuf[(size_t)(u.pm * BM + prow_) * 4 + u.pn] = (p4[0] + p4[1]) + (p4[2] + p4[3]); } }
            asm volatile("s_waitcnt lgkmcnt(0)" ::: "memory"); __builtin_amdgcn_s_barrier(); asm volatile("" ::: "memory");
            return;
        }
        const int lane = lane_id(), wid = wr * 4 + wc;
        PG8_LAS float* P = (PG8_LAS float*)ldsx; PG8_LAS float* S = (PG8_LAS float*)(ldsx + 4096);
        {
            f32x4 g[2][2];
#pragma unroll
            for (int bj = 0; bj < 2; ++bj)
#pragma unroll
                for (int n = 0; n < 2; ++n) g[bj][n] = *(const f32x4*)(mb + gslot * DM + bj * HALF + n * 4);
            if (BASE_BF16) {
#pragma unroll
                for (int ai = 0; ai < 2; ++ai) {
                    u32x2 bb[4][2][2];
#pragma unroll
                    for (int m = 0; m < 4; ++m) { const size_t off = (size_t)(row0 + ai * HALF + m * 16) * DM + col0;
#pragma unroll
                        for (int bj = 0; bj < 2; ++bj)
#pragma unroll
                            for (int n = 0; n < 2; ++n) bb[m][bj][n] = *(const u32x2*)((const bf16_t*)base_ + off + bj * HALF + n * 4); }
#pragma unroll
                    for (int m = 0; m < 4; ++m) { float ss = 0.f;
#pragma unroll
                        for (int bj = 0; bj < 2; ++bj)
#pragma unroll
                            for (int n = 0; n < 2; ++n) { const u32x2 w = bb[m][bj][n];
                                const f32x4 b = (f32x4){__uint_as_float(w.x << 16), __uint_as_float(w.x & 0xffff0000u), __uint_as_float(w.y << 16), __uint_as_float(w.y & 0xffff0000u)};
                                const f32x4 h = b + g[bj][n] * acc[ai][bj][m][n]; acc[ai][bj][m][n] = h; ss += sumsq4(h); }
                        ss += __shfl_xor(ss, 16); ss += __shfl_xor(ss, 32);
                        if (fq == 0) P[(rt0 + ai * HALF + m * 16) * 4 + wc] = ss; }
                    asm volatile("" ::: "memory");
                }
            } else {
#pragma unroll
                for (int ai = 0; ai < 2; ++ai)
#pragma unroll
                    for (int m = 0; m < 4; ++m) { const size_t off = (size_t)(row0 + ai * HALF + m * 16) * DM + col0; float ss = 0.f;
#pragma unroll
                        for (int bj = 0; bj < 2; ++bj)
#pragma unroll
                            for (int n = 0; n < 2; ++n) { const f32x4 b = *(const f32x4*)((const float*)base_ + off + bj * HALF + n * 4); const f32x4 h = b + g[bj][n] * acc[ai][bj][m][n]; acc[ai][bj][m][n] = h; ss += sumsq4(h); }
                        ss += __shfl_xor(ss, 16); ss += __shfl_xor(ss, 32);
                        if (fq == 0) P[(rt0 + ai * HALF + m * 16) * 4 + wc] = ss;
                        if (m & 1) asm volatile("" ::: "memory"); }
            }
        }
        asm volatile("s_waitcnt lgkmcnt(0)" ::: "memory"); __builtin_amdgcn_s_barrier(); asm volatile("" ::: "memory");
        const int prow = wid * 32 + (lane & 31);
        float* slot = xbuf + ((size_t)(u.pm * BM + prow) * 4);
        if (lane < 32) { const f32x4 p4 = *(const PG8_LAS f32x4*)(P + prow * 4); __hip_atomic_store(slot + u.pn, (p4[0] + p4[1]) + (p4[2] + p4[3]), __ATOMIC_RELAXED, __HIP_MEMORY_SCOPE_AGENT); }
        asm volatile("s_waitcnt vmcnt(0)" ::: "memory");
        unsigned* cw = cnt + 64 * u.pm;
        if (lane == 0) __hip_atomic_fetch_add(cw, 1u, __ATOMIC_RELAXED, __HIP_MEMORY_SCOPE_AGENT);
        { unsigned sp = 0;
          while ((unsigned)__builtin_amdgcn_readfirstlane(__hip_atomic_load(cw, __ATOMIC_RELAXED, __HIP_MEMORY_SCOPE_AGENT)) < want) { __builtin_amdgcn_s_sleep(1); if (++sp > (1u << 22)) break; } }
        __builtin_amdgcn_fence(__ATOMIC_ACQUIRE, "agent");
        if (lane < 32) {
            const unsigned long long w0 = __hip_atomic_load((const unsigned long long*)slot, __ATOMIC_RELAXED, __HIP_MEMORY_SCOPE_AGENT), w1 = __hip_atomic_load((const unsigned long long*)slot + 1, __ATOMIC_RELAXED, __HIP_MEMORY_SCOPE_AGENT);
            const float s = (__uint_as_float((unsigned)w0) + __uint_as_float((unsigned)(w0 >> 32))) + (__uint_as_float((unsigned)w1) + __uint_as_float((unsigned)(w1 >> 32)));
            S[prow] = __builtin_amdgcn_rsqf(s * (1.f / DM) + NORM_EPS);
        }
        f32x4 av[2][2], sv[2][2];
#pragma unroll
        for (int bj = 0; bj < 2; ++bj)
#pragma unroll
            for (int n = 0; n < 2; ++n) {
                if (FINAL) { av[bj][n] = *(const f32x4*)(fn + col0 + bj * HALF + n * 4); sv[bj][n] = (f32x4){0.f, 0.f, 0.f, 0.f}; }
                else { av[bj][n] = *(const f32x4*)(mb + (sslot + 1) * DM + bj * HALF + n * 4); sv[bj][n] = *(const f32x4*)(mb + sslot * DM + bj * HALF + n * 4); } }
        asm volatile("s_waitcnt lgkmcnt(0)" ::: "memory"); __builtin_amdgcn_s_barrier(); asm volatile("" ::: "memory");
#pragma unroll
        for (int ai = 0; ai < 2; ++ai)
#pragma unroll
            for (int m = 0; m < 4; ++m) {
                const size_t off = (size_t)(row0 + ai * HALF + m * 16) * DM + col0; const float r = S[rt0 + ai * HALF + m * 16];
#pragma unroll
                for (int bj = 0; bj < 2; ++bj)
#pragma unroll
                    for (int n = 0; n < 2; ++n) { const f32x4 h = acc[ai][bj][m][n];
                        if (FINAL) { *(f32x4*)((float*)out_ + off + bj * HALF + n * 4) = h * r * av[bj][n]; }
                        else { if (OUT_BF16) *(u32x2*)((bf16_t*)out_ + off + bj * HALF + n * 4) = pack4(h); else *(f32x4*)((float*)out_ + off + bj * HALF + n * 4) = h;
                               *(u32x2*)(U + off + bj * HALF + n * 4) = pack4(h * r * av[bj][n] + sv[bj][n]); } }
            }
        asm volatile("s_waitcnt lgkmcnt(0)" ::: "memory"); __builtin_amdgcn_s_barrier(); asm volatile("" ::: "memory");
    }
};
struct EpiProj {
    static constexpr bool PERM = true, AFTER_DRAIN = false, MIDK = false;
    unsigned char* ws;
    __device__ __forceinline__ void operator()(f32x4 (&acc)[2][2][4][2], const Unit& u, int wr, int wc, int fr, int fq) const {
        asm volatile("" : "+v"(fr), "+v"(fq));
        deferred_norm_fixup(acc, u, wr, wc, fr, fq, (const float*)(ws + WS_XBUF), (const float*)(ws + WS_CV1), 2304);
        const int pn = u.pn, row0 = u.pm * BM + wr * 64 + fr;
        bf16_t* const DQ = (bf16_t*)(ws + WS_DQ); bf16_t* const DK = (bf16_t*)(ws + WS_DK); bf16_t* const DV = (bf16_t*)(ws + WS_DV); bf16_t* const CQ = (bf16_t*)(ws + WS_CQ); bf16_t* const CKV = (bf16_t*)(ws + WS_CKV); bf16_t* const KR = (bf16_t*)(ws + WS_KR);
        float* const SSCQ = (float*)(ws + WS_SSCQ); float* const SSCKV = (float*)(ws + WS_SSCKV);
        const float* const COSD = (const float*)(ws + WS_COSD); const float* const SIND = (const float*)(ws + WS_SIND); const float* const COSR = (const float*)(ws + WS_COSR); const float* const SINR = (const float*)(ws + WS_SINR);
        if (pn < 4) {
            bf16_t* dst = (pn < 2) ? DQ : DK; const float sc = (pn < 2) ? QSC_DIFF : 1.f; const int colb = 256 * (pn & 1) + 64 * wc + 8 * fq;
#pragma unroll
            for (int ai = 0; ai < 2; ++ai)
#pragma unroll
                for (int m = 0; m < 4; ++m) {
                    const int row = row0 + ai * HALF + m * 16;
                    const f32x4 c0 = *(const f32x4*)(COSD + (size_t)row * 32 + 8 * fq), c1 = *(const f32x4*)(COSD + (size_t)row * 32 + 8 * fq + 4);
                    const f32x4 s0 = *(const f32x4*)(SIND + (size_t)row * 32 + 8 * fq), s1 = *(const f32x4*)(SIND + (size_t)row * 32 + 8 * fq + 4);
                    const f32x4 x1a = acc[ai][0][m][0], x1b = acc[ai][0][m][1], x2a = acc[ai][1][m][0], x2b = acc[ai][1][m][1];
                    const f32x4 y1a = (x1a * c0 - x2a * s0) * sc, y1b = (x1b * c1 - x2b * s1) * sc, y2a = (x2a * c0 + x1a * s0) * sc, y2b = (x2b * c1 + x1b * s1) * sc;
                    bf16_t* rp = dst + (size_t)row * 512 + colb;
                    *(u32x4*)rp = pack8(y1a, y1b); *(u32x4*)(rp + 32) = pack8(y2a, y2b);
                    asm volatile("" ::: "memory");
                }
        } else if (pn < 6) {
            const int colb = 256 * (pn - 4) + 32 * wc + 8 * fq;
#pragma unroll
            for (int ai = 0; ai < 2; ++ai)
#pragma unroll
                for (int m = 0; m < 4; ++m) { bf16_t* rp = DV + (size_t)(row0 + ai * HALF + m * 16) * 512 + colb;
#pragma unroll
                    for (int bj = 0; bj < 2; ++bj) *(u32x4*)(rp + bj * HALF) = pack8(acc[ai][bj][m][0], acc[ai][bj][m][1]); }
        } else if (pn == 6) {
            const int colb = 32 * wc + 8 * fq;
#pragma unroll
            for (int ai = 0; ai < 2; ++ai)
#pragma unroll
                for (int m = 0; m < 4; ++m) { const int row = row0 + ai * HALF + m * 16; bf16_t* rp = CQ + (size_t)row * 384 + colb; float ss = 0.f;
#pragma unroll
                    for (int bj = 0; bj < 2; ++bj) { *(u32x4*)(rp + bj * HALF) = pack8(acc[ai][bj][m][0], acc[ai][bj][m][1]); ss += sumsq4(acc[ai][bj][m][0]) + sumsq4(acc[ai][bj][m][1]); }
                    ss += __shfl_xor(ss, 16); ss += __shfl_xor(ss, 32); if (fq == 0) SSCQ[(size_t)row * 8 + wc] = ss; }
        } else if (pn == 7) {
#pragma unroll
            for (int ai = 0; ai < 2; ++ai)
#pragma unroll
                for (int m = 0; m < 4; ++m) { const int row = row0 + ai * HALF + m * 16; bf16_t* rp = CQ + (size_t)row * 384 + 256 + 32 * wc + 8 * fq;
                    *(u32x4*)rp = pack8(acc[ai][0][m][0], acc[ai][0][m][1]); float ss = sumsq4(acc[ai][0][m][0]) + sumsq4(acc[ai][0][m][1]);
                    ss += __shfl_xor(ss, 16); ss += __shfl_xor(ss, 32); if (fq == 0) SSCQ[(size_t)row * 8 + 4 + wc] = ss;
                    if (wc == 0) {
                        const f32x4 c = *(const f32x4*)(COSR + (size_t)row * 16 + 4 * fq), s = *(const f32x4*)(SINR + (size_t)row * 16 + 4 * fq);
                        const f32x4 x1 = acc[ai][1][m][0], x2 = acc[ai][1][m][1];
                        bf16_t* kp = KR + (size_t)row * 32 + 4 * fq;
                        *(u32x2*)kp = pack4(x1 * c - x2 * s); *(u32x2*)(kp + 16) = pack4(x2 * c + x1 * s);
                    } }
        } else {
            const int colb = 32 * wc + 8 * fq;
#pragma unroll
            for (int ai = 0; ai < 2; ++ai)
#pragma unroll
                for (int m = 0; m < 4; ++m) { const int row = row0 + ai * HALF + m * 16; bf16_t* rp = CKV + (size_t)row * 256 + colb; float ss = 0.f;
#pragma unroll
                    for (int bj = 0; bj < 2; ++bj) { *(u32x4*)(rp + bj * HALF) = pack8(acc[ai][bj][m][0], acc[ai][bj][m][1]); ss += sumsq4(acc[ai][bj][m][0]) + sumsq4(acc[ai][bj][m][1]); }
                    ss += __shfl_xor(ss, 16); ss += __shfl_xor(ss, 32); if (fq == 0) SSCKV[(size_t)row * 4 + wc] = ss; }
        }
    }
};
struct EpiUq {
    static constexpr bool PERM = true, AFTER_DRAIN = false, MIDK = false;
    unsigned char* ws;
    __device__ __forceinline__ void operator()(const f32x4 (&acc)[2][2][4][2], const Unit& u, int wr, int wc, int fr, int fq) const {
        const int pn = u.pn, row0 = u.pm * BM + wr * 64 + fr;
        bf16_t* const MQ = (bf16_t*)(ws + WS_MQ); const float* const SSCQ = (const float*)(ws + WS_SSCQ); const float* const COSR = (const float*)(ws + WS_COSR); const float* const SINR = (const float*)(ws + WS_SINR);
#pragma unroll
        for (int ai = 0; ai < 2; ++ai)
#pragma unroll
            for (int m = 0; m < 4; ++m) { const int row = row0 + ai * HALF + m * 16;
                const f32x4 sa = *(const f32x4*)(SSCQ + (size_t)row * 8), sb = *(const f32x4*)(SSCQ + (size_t)row * 8 + 4);
                const float ssq = ((sa[0] + sa[1]) + (sa[2] + sa[3])) + ((sb[0] + sb[1]) + (sb[2] + sb[3]));
                const float r = __builtin_amdgcn_rsqf(ssq * (1.f / 384.f) + NORM_EPS) * QSC_MLA;
                bf16_t* hp = MQ + (size_t)row * 384 + (2 * pn + (wc >> 1)) * 96 + 32 * (wc & 1) + 8 * fq;
                *(u32x4*)hp = pack8(acc[ai][0][m][0] * r, acc[ai][0][m][1] * r);
                if (wc < 2) {
                    const f32x4 c = *(const f32x4*)(COSR + (size_t)row * 16 + 4 * fq), s = *(const f32x4*)(SINR + (size_t)row * 16 + 4 * fq);
                    const f32x4 x1 = acc[ai][1][m][0] * r, x2 = acc[ai][1][m][1] * r;
                    bf16_t* rp = MQ + (size_t)row * 384 + (2 * pn + wc) * 96 + 64 + 4 * fq;
                    *(u32x2*)rp = pack4(x1 * c - x2 * s); *(u32x2*)(rp + 16) = pack4(x2 * c + x1 * s);
                }
                asm volatile("" ::: "memory"); }
    }
};
struct EpiUkv {
    static constexpr bool PERM = true, AFTER_DRAIN = false, MIDK = false;
    unsigned char* ws;
    __device__ __forceinline__ void operator()(const f32x4 (&acc)[2][2][4][2], const Unit& u, int wr, int wc, int fr, int fq) const {
        const int pn = u.pn, row0 = u.pm * BM + wr * 64 + fr;
        bf16_t* const MK = (bf16_t*)(ws + WS_MK); bf16_t* const MV = (bf16_t*)(ws + WS_MV); const float* const SSCKV = (const float*)(ws + WS_SSCKV);
#pragma unroll
        for (int ai = 0; ai < 2; ++ai)
#pragma unroll
            for (int m = 0; m < 4; ++m) { const int row = row0 + ai * HALF + m * 16;
                const f32x4 sa = *(const f32x4*)(SSCKV + (size_t)row * 4);
                const float r = __builtin_amdgcn_rsqf(((sa[0] + sa[1]) + (sa[2] + sa[3])) * (1.f / 256.f) + NORM_EPS);
                bf16_t* rp = (pn == 0) ? (MK + (size_t)row * 256 + 32 * wc + 8 * fq) : (MV + (size_t)row * 512 + 256 * (pn - 1) + 32 * wc + 8 * fq);
#pragma unroll
                for (int bj = 0; bj < 2; ++bj) *(u32x4*)(rp + bj * HALF) = pack8(acc[ai][bj][m][0] * r, acc[ai][bj][m][1] * r);
                asm volatile("" ::: "memory"); }
    }
};
}

#define LAS __attribute__((address_space(3)))
namespace att {
typedef unsigned short bf16_t;
typedef short bf16x8 __attribute__((ext_vector_type(8)));
typedef short s16x4 __attribute__((ext_vector_type(4)));
typedef float f32x16 __attribute__((ext_vector_type(16)));
typedef float f32x4 __attribute__((ext_vector_type(4)));
typedef unsigned u32x4 __attribute__((ext_vector_type(4)));
typedef unsigned u32x2 __attribute__((ext_vector_type(2)));
constexpr int KBUF = 13312, VBUF = 16384, KOFF = 0, VOFF = 2 * KBUF, ATT_LDS = VOFF + 2 * VBUF;
__device__ __forceinline__ int crow(int r, int hi) { return (r & 3) + 8 * (r >> 2) + 4 * hi; }
__device__ __forceinline__ unsigned cvtpk(float lo, float hi) { unsigned r; asm volatile("v_cvt_pk_bf16_f32 %0, %1, %2" : "=v"(r) : "v"(lo), "v"(hi)); return r; }
__device__ __forceinline__ s16x4 vtr(const LAS unsigned char* p) { return __builtin_bit_cast(s16x4, __builtin_amdgcn_ds_read_tr16_b64_v4i16((LAS s16x4*)p)); }

__device__ __forceinline__ void glds16(const void* gsrc, unsigned lds_dst) { unsigned keep;
    asm volatile("s_mov_b32 %0, m0\n\ts_mov_b32 m0, %2\n\ts_nop 0\n\tglobal_load_lds_dwordx4 %1, off\n\ts_mov_b32 m0, %0" : "=&s"(keep) : "v"(gsrc), "s"(lds_dst) : "memory"); }
struct PassArgs { const bf16_t* Q; int pq; const bf16_t* K1; int pk1; const bf16_t* K2; int pk2; const bf16_t* V; int pv; };

template <int DQK>
__device__ __forceinline__ void flash_pass(f32x16 (&o)[4], float& l_out, const PassArgs& a, int q0, LAS unsigned char* lds, int tid, int wid, int lane) {
    const int r32 = lane & 31, hi = lane >> 5;
    bf16x8 qr[DQK / 16];
    { const bf16_t* qp = a.Q + (size_t)(q0 + wid * 32 + r32) * a.pq + hi * 8;
#pragma unroll
      for (int d0 = 0; d0 < DQK / 16; ++d0) qr[d0] = *(const bf16x8*)(qp + d0 * 16); }
    const unsigned kgo0 = (unsigned)(lane * a.pk1 + wid * 8) * 2u, kgo1 = (unsigned)(lane * a.pk2 + (wid & 3) * 8) * 2u;
    const size_t kstep0 = (size_t)(64 * a.pk1) * 2, kstep1 = (size_t)(64 * a.pk2) * 2, vstep = (size_t)(64 * a.pv) * 2;
    unsigned vgo[2];
#pragma unroll
    for (int i = 0; i < 2; ++i) { const int p = wid + 8 * i; vgo[i] = (unsigned)((16 * (p & 3) + (lane >> 2)) * a.pv + (4 * (p >> 2) + (lane & 3)) * 8) * 2u; }
    const int NT = (q0 + 256) >> 6;
    const int wq_lo = q0 + wid * 32, qrow = wq_lo + r32;
    float m_ref = -1e30f, l_run = 0.f;
#pragma unroll
    for (int db = 0; db < 4; ++db)
#pragma unroll
        for (int r = 0; r < 16; ++r) o[db][r] = 0.f;
    const unsigned kfo = (unsigned)(hi * 1024 + r32 * 16);
    const unsigned vfo = (unsigned)((4 * hi + ((lane & 15) >> 2)) * 64 + ((lane >> 4) & 1) * 32 + (lane & 3) * 8);
#define ATT_GLDS(g, l) glds16((const void*)(g), (unsigned)__builtin_amdgcn_readfirstlane((int)(unsigned)(uintptr_t)(l)))
#define ATT_DMAK(t, b) do { ATT_GLDS((const char*)a.K1 + (size_t)(t) * kstep0 + kgo0, lds + KOFF + (b) * KBUF + wid * 1024); \
        if (DQK == 96 && wid < 4) ATT_GLDS((const char*)a.K2 + (size_t)(t) * kstep1 + kgo1, lds + KOFF + (b) * KBUF + (8 + wid) * 1024); } while (0)
#define ATT_DMAV(t, b) do { _Pragma("unroll") for (int i = 0; i < 2; ++i) ATT_GLDS((const char*)a.V + (size_t)(t) * vstep + vgo[i], lds + VOFF + (b) * VBUF + (wid + 8 * i) * 1024); } while (0)
#define ATT_SYNC() do { asm volatile("s_waitcnt vmcnt(0)" ::: "memory"); __syncthreads(); } while (0)
#define ATT_SB() __builtin_amdgcn_sched_barrier(0)
#define ATT_KRD(dst, kb_, d0) do { dst[0] = *(const LAS bf16x8*)(kb_ + (d0) * 2048); dst[1] = *(const LAS bf16x8*)(kb_ + (d0) * 2048 + 512); } while (0)
#define ATT_KMM(P0, P1, src, d0) do { \
        if ((d0) == 0) { P0 = __builtin_amdgcn_mfma_f32_32x32x16_bf16(src[0], qr[d0], zero16, 0, 0, 0); P1 = __builtin_amdgcn_mfma_f32_32x32x16_bf16(src[1], qr[d0], zero16, 0, 0, 0); } \
        else { P0 = __builtin_amdgcn_mfma_f32_32x32x16_bf16(src[0], qr[d0], P0, 0, 0, 0); P1 = __builtin_amdgcn_mfma_f32_32x32x16_bf16(src[1], qr[d0], P1, 0, 0, 0); } } while (0)
#define ATT_QK(P0, P1, b) do { const LAS unsigned char* kb_ = lds + KOFF + (b) * KBUF + kfo; bf16x8 ka_[2], kc_[2]; \
        ATT_KRD(ka_, kb_, 0); ATT_SB(); ATT_KRD(kc_, kb_, 1); ATT_SB(); ATT_KMM(P0, P1, ka_, 0); ATT_SB(); \
        ATT_KRD(ka_, kb_, 2); ATT_SB(); ATT_KMM(P0, P1, kc_, 1); ATT_SB(); \
        ATT_KRD(kc_, kb_, 3); ATT_SB(); ATT_KMM(P0, P1, ka_, 2); ATT_SB(); \
        if (DQK == 96) { ATT_KRD(ka_, kb_, 4); ATT_SB(); } \
        ATT_KMM(P0, P1, kc_, 3); ATT_SB(); \
        if (DQK == 96) { ATT_KRD(kc_, kb_, 5); ATT_SB(); ATT_KMM(P0, P1, ka_, 4); ATT_SB(); ATT_KMM(P0, P1, kc_, 5); ATT_SB(); } } while (0)
#define ATT_VRD(dst, vb_, j) do { _Pragma("unroll") for (int s_ = 0; s_ < 2; ++s_) { dst[2 * s_] = vtr(vb_ + (((j) >> 1) * 4 + 2 * ((j) & 1) + s_) * 1024); dst[2 * s_ + 1] = vtr(vb_ + (((j) >> 1) * 4 + 2 * ((j) & 1) + s_) * 1024 + 512); } } while (0)
#define ATT_VMM(PW, src, j) do { _Pragma("unroll") for (int s_ = 0; s_ < 2; ++s_) { \
        const bf16x8 vf_ = (bf16x8){src[2 * s_][0], src[2 * s_][1], src[2 * s_][2], src[2 * s_][3], src[2 * s_ + 1][0], src[2 * s_ + 1][1], src[2 * s_ + 1][2], src[2 * s_ + 1][3]}; \
        o[(j) >> 1] = __builtin_amdgcn_mfma_f32_32x32x16_bf16(vf_, __builtin_bit_cast(bf16x8, PW[2 * ((j) & 1) + s_]), o[(j) >> 1], 0, 0, 0); } } while (0)
#define ATT_PV(PW, b) do { const LAS unsigned char* vb_ = lds + VOFF + (b) * VBUF + vfo; s16x4 va_[4], vc_[4]; \
        ATT_VRD(va_, vb_, 0); ATT_SB(); \
        ATT_VRD(vc_, vb_, 1); ATT_SB(); ATT_VMM(PW, va_, 0); ATT_SB(); ATT_VRD(va_, vb_, 2); ATT_SB(); ATT_VMM(PW, vc_, 1); ATT_SB(); \
        ATT_VRD(vc_, vb_, 3); ATT_SB(); ATT_VMM(PW, va_, 2); ATT_SB(); ATT_VRD(va_, vb_, 4); ATT_SB(); ATT_VMM(PW, vc_, 3); ATT_SB(); \
        ATT_VRD(vc_, vb_, 5); ATT_SB(); ATT_VMM(PW, va_, 4); ATT_SB(); ATT_VRD(va_, vb_, 6); ATT_SB(); ATT_VMM(PW, vc_, 5); ATT_SB(); \
        ATT_VRD(vc_, vb_, 7); ATT_SB(); ATT_VMM(PW, va_, 6); ATT_SB(); ATT_VMM(PW, vc_, 7); ATT_SB(); } while (0)
#define ATT_SOFTMAX(t, P0, P1, PW) do { \
        if (64 * (t) + 63 > wq_lo) { const int kb0_ = 64 * (t) + 4 * hi; \
            _Pragma("unroll") for (int r = 0; r < 16; ++r) { const int kv_ = kb0_ + (r & 3) + 8 * (r >> 2); if (kv_ > qrow) P0[r] = -1e30f; if (kv_ + 32 > qrow) P1[r] = -1e30f; } } \
        float mxa_ = __builtin_fmaxf(__builtin_fmaxf(P0[0], P0[1]), P1[0]), mxb_ = __builtin_fmaxf(__builtin_fmaxf(P0[2], P0[3]), P1[1]); mxa_ = __builtin_fmaxf(__builtin_fmaxf(mxa_, P1[2]), P1[3]); \
        _Pragma("unroll") for (int r = 4; r < 16; r += 4) { mxa_ = __builtin_fmaxf(__builtin_fmaxf(mxa_, P0[r]), P0[r + 1]); mxb_ = __builtin_fmaxf(__builtin_fmaxf(mxb_, P0[r + 2]), P0[r + 3]); \
                                                             mxa_ = __builtin_fmaxf(__builtin_fmaxf(mxa_, P1[r]), P1[r + 1]); mxb_ = __builtin_fmaxf(__builtin_fmaxf(mxb_, P1[r + 2]), P1[r + 3]); } \
        float mx_ = __builtin_fmaxf(mxa_, mxb_); \
        { auto rr_ = __builtin_amdgcn_permlane32_swap(__float_as_uint(mx_), __float_as_uint(mx_), false, false); mx_ = __builtin_fmaxf(__uint_as_float(rr_[0]), __uint_as_float(rr_[1])); }     \
        if (__any(mx_ > m_ref + 8.f)) { const float mn_ = fmaxf(m_ref, mx_), al_ = __builtin_amdgcn_exp2f(m_ref - mn_); m_ref = mn_; l_run *= al_; \
            _Pragma("unroll") for (int db = 0; db < 4; ++db) _Pragma("unroll") for (int r = 0; r < 16; ++r) o[db][r] *= al_; } \
        float rs_ = 0.f; \
        _Pragma("unroll") for (int r = 0; r < 16; ++r) { P0[r] = __builtin_amdgcn_exp2f(P0[r] - m_ref); P1[r] = __builtin_amdgcn_exp2f(P1[r] - m_ref); rs_ += P0[r] + P1[r]; } \
        l_run += rs_; \
        _Pragma("unroll") for (int j = 0; j < 4; ++j) { PW[0][j] = cvtpk(P0[2 * j], P0[2 * j + 1]); PW[1][j] = cvtpk(P0[8 + 2 * j], P0[9 + 2 * j]); PW[2][j] = cvtpk(P1[2 * j], P1[2 * j + 1]); PW[3][j] = cvtpk(P1[8 + 2 * j], P1[9 + 2 * j]); } } while (0)
#define ATT_NEED(t) (64 * (t) <= wq_lo + 31)
#define ATT_MXC(P0, P1, j) do { mxa_ = __builtin_fmaxf(__builtin_fmaxf(mxa_, P0[2 * (j)]), P0[2 * (j) + 1]); mxb_ = __builtin_fmaxf(__builtin_fmaxf(mxb_, P1[2 * (j)]), P1[2 * (j) + 1]); } while (0)
#define ATT_EXC(P0, P1, PW, c) do { _Pragma("unroll") for (int r = 4 * (c); r < 4 * (c) + 4; ++r) { P0[r] = __builtin_amdgcn_exp2f(P0[r] - m_ref); P1[r] = __builtin_amdgcn_exp2f(P1[r] - m_ref); rs_ += P0[r] + P1[r]; } \
        PW[(c) >> 1][2 * ((c) & 1)] = cvtpk(P0[4 * (c)], P0[4 * (c) + 1]); PW[(c) >> 1][2 * ((c) & 1) + 1] = cvtpk(P0[4 * (c) + 2], P0[4 * (c) + 3]); \
        PW[2 + ((c) >> 1)][2 * ((c) & 1)] = cvtpk(P1[4 * (c)], P1[4 * (c) + 1]); PW[2 + ((c) >> 1)][2 * ((c) & 1) + 1] = cvtpk(P1[4 * (c) + 2], P1[4 * (c) + 3]); } while (0)
#define ATT_FAST(SE0, SE1, SO0, SO1, PAR) do { \
        { const LAS unsigned char* vb_ = lds + VOFF + (1 - (PAR)) * VBUF + vfo; s16x4 va_[4], vc_[4]; float mxa_ = -3.0e38f, mxb_ = -3.0e38f; \
          ATT_VRD(va_, vb_, 0); ATT_SB(); \
          ATT_VRD(vc_, vb_, 1); ATT_SB(); ATT_VMM(pwa, va_, 0); ATT_MXC(SE0, SE1, 0); ATT_SB(); ATT_VRD(va_, vb_, 2); ATT_SB(); ATT_VMM(pwa, vc_, 1); ATT_MXC(SE0, SE1, 1); ATT_SB(); \
          ATT_VRD(vc_, vb_, 3); ATT_SB(); ATT_VMM(pwa, va_, 2); ATT_MXC(SE0, SE1, 2); ATT_SB(); ATT_VRD(va_, vb_, 4); ATT_SB(); ATT_VMM(pwa, vc_, 3); ATT_MXC(SE0, SE1, 3); ATT_SB(); \
          ATT_VRD(vc_, vb_, 5); ATT_SB(); ATT_VMM(pwa, va_, 4); ATT_MXC(SE0, SE1, 4); ATT_SB(); ATT_VRD(va_, vb_, 6); ATT_SB(); ATT_VMM(pwa, vc_, 5); ATT_MXC(SE0, SE1, 5); ATT_SB(); \
          ATT_VRD(vc_, vb_, 7); ATT_SB(); ATT_VMM(pwa, va_, 6); ATT_MXC(SE0, SE1, 6); ATT_SB(); ATT_VMM(pwa, vc_, 7); ATT_MXC(SE0, SE1, 7); ATT_SB(); \
          float mx_ = __builtin_fmaxf(mxa_, mxb_); \
          { auto rr_ = __builtin_amdgcn_permlane32_swap(__float_as_uint(mx_), __float_as_uint(mx_), false, false); mx_ = __builtin_fmaxf(__uint_as_float(rr_[0]), __uint_as_float(rr_[1])); } \
          if (__any(mx_ > m_ref + 8.f)) { const float mn_ = fmaxf(m_ref, mx_), al_ = __builtin_amdgcn_exp2f(m_ref - mn_); m_ref = mn_; l_run *= al_; \
              _Pragma("unroll") for (int db = 0; db < 4; ++db) _Pragma("unroll") for (int r = 0; r < 16; ++r) o[db][r] *= al_; } } \
        { const LAS unsigned char* kb_ = lds + KOFF + (1 - (PAR)) * KBUF + kfo; bf16x8 ka_[2], kc_[2]; float rs_ = 0.f; \
          ATT_KRD(ka_, kb_, 0); ATT_SB(); ATT_KRD(kc_, kb_, 1); ATT_SB(); ATT_KMM(SO0, SO1, ka_, 0); ATT_EXC(SE0, SE1, pwa, 0); ATT_SB(); \
          ATT_KRD(ka_, kb_, 2); ATT_SB(); ATT_KMM(SO0, SO1, kc_, 1); ATT_EXC(SE0, SE1, pwa, 1); ATT_SB(); \
          ATT_KRD(kc_, kb_, 3); ATT_SB(); ATT_KMM(SO0, SO1, ka_, 2); ATT_EXC(SE0, SE1, pwa, 2); ATT_SB(); \
          if (DQK == 96) { ATT_KRD(ka_, kb_, 4); ATT_SB(); } \
          ATT_KMM(SO0, SO1, kc_, 3); ATT_EXC(SE0, SE1, pwa, 3); ATT_SB(); \
          if (DQK == 96) { ATT_KRD(kc_, kb_, 5); ATT_SB(); ATT_KMM(SO0, SO1, ka_, 4); ATT_SB(); ATT_KMM(SO0, SO1, kc_, 5); ATT_SB(); } \
          l_run += rs_; } } while (0)
#define ATT_IVAL(GRP, t, PAR, SE0, SE1, SO0, SO1) do { \
        if ((t) < NT) { if ((t) + 2 < NT) ATT_DMAK((t) + 2, PAR); ATT_DMAV(t, PAR); } \
        if (GRP == 0) { \
            if ((t) + 1 < NT && ATT_NEED((t) + 1)) ATT_QK(SO0, SO1, 1 - (PAR)); \
            if ((t) >= 1 && ATT_NEED((t) - 1)) ATT_PV(pwa, 1 - (PAR)); \
            if ((t) < NT && ATT_NEED(t)) ATT_SOFTMAX(t, SE0, SE1, pwa); \
        } else { \
            if ((t) >= 1 && ATT_NEED((t) - 1)) { ATT_SOFTMAX((t) - 1, SO0, SO1, pwa); ATT_PV(pwa, 1 - (PAR)); } \
            if ((t) + 1 < NT && ATT_NEED((t) + 1)) ATT_QK(SO0, SO1, 1 - (PAR)); \
        } \
        ATT_SYNC(); } while (0)
    f32x16 sa0, sa1, sb0, sb1; u32x4 pwa[4]; f32x16 zero16;
#pragma unroll
    for (int r = 0; r < 16; ++r) zero16[r] = 0.f;
#pragma unroll
    for (int j = 0; j < 4; ++j) pwa[j] = (u32x4){0u, 0u, 0u, 0u};
#ifdef T_GRP
    const int grp = T_GRP;
#else
    const int grp = wid >> 2;
#endif
    ATT_DMAK(0, 0); ATT_DMAK(1, 1); ATT_SYNC();
    ATT_QK(sa0, sa1, 0);
    __syncthreads();
    (void)grp;
#define ATT_FIVAL(t, PAR, SE0, SE1, SO0, SO1) do { if ((t) + 2 < NT) ATT_DMAK((t) + 2, PAR); ATT_DMAV(t, PAR); ATT_FAST(SE0, SE1, SO0, SO1, PAR); ATT_SYNC(); } while (0)
    const int tfmax = (wq_lo >= 127) ? ((wq_lo - 63) >> 6) - 1 : 0;
    ATT_IVAL(0, 0, 0, sa0, sa1, sb0, sb1);
    int t = 1;
    for (; t + 1 <= tfmax; t += 2) {
        ATT_FIVAL(t, 1, sb0, sb1, sa0, sa1);
        ATT_FIVAL(t + 1, 0, sa0, sa1, sb0, sb1);
    }
    for (; t < NT; t += 2) {
        ATT_IVAL(0, t, 1, sb0, sb1, sa0, sa1);
        ATT_IVAL(0, t + 1, 0, sa0, sa1, sb0, sb1);
    }
#undef ATT_FIVAL
#undef ATT_GLDS
#undef ATT_DMAK
#undef ATT_DMAV
#undef ATT_SYNC
#undef ATT_QK
#undef ATT_SB
#undef ATT_KRD
#undef ATT_KMM
#undef ATT_VRD
#undef ATT_VMM
#undef ATT_PV
#undef ATT_SOFTMAX
#undef ATT_NEED
#undef ATT_IVAL
#undef ATT_FAST
#undef ATT_MXC
#undef ATT_EXC
    l_out = l_run + __shfl_xor(l_run, 32);
}
}

constexpr int LDS_BYTES = 147456, MISC_OFF = 131072 + 8192;
typedef unsigned short bf16_t;
typedef float f32x4 __attribute__((ext_vector_type(4)));
typedef unsigned u32x4 __attribute__((ext_vector_type(4)));
typedef unsigned u32x2 __attribute__((ext_vector_type(2)));

struct Args { const void* in[27]; float* out; unsigned char* ws; unsigned long long use_cg; };

__device__ __forceinline__ float wave_sum(float v) {
#pragma unroll
    for (int o = 1; o < 64; o <<= 1) v += __shfl_xor(v, o);
    return v;
}
__device__ __forceinline__ unsigned f2bf(float f) { unsigned u = __builtin_bit_cast(unsigned, f); return (u + 0x7fffu + ((u >> 16) & 1u)) >> 16; }
__device__ __forceinline__ unsigned pk2(float lo, float hi) { return f2bf(lo) | (f2bf(hi) << 16); }

enum { WK_GU = 0, WK_PLAIN = 1, WK_IN = 2, WK_UQ = 3, WK_UKV = 4, WK_OUT = 5 };
template <int KIND>
__device__ __forceinline__ void transpose_item(const float* W, const float* W2, const float* ks1, const float* ks2, int K, int Nsrc, int Ndst, bf16_t* WT, LAS float* scr, int item, int lane) {
    const int nblk = Ndst / 32, kb = item / nblk, nb = item % nblk, k0 = 64 * kb, n0 = 32 * nb;
    const int np = n0 + (lane & 31);
    const float* src = W; int sc = np; bool valid = true;
    if (KIND == WK_GU) { const int tile = np >> 8, p = np & 255; src = (p >> 7) ? W2 : W; sc = tile * 128 + (p & 127); }
    else if (KIND == WK_IN) { const int tile = np >> 8, p = np & 255, bj = p >> 7, wc = (p & 127) >> 5, j = p & 31;
        if (tile < 4) sc = 256 * tile + 64 * wc + 32 * bj + j;
        else if (tile < 6) sc = 256 * tile + p;
        else if (tile == 6) sc = 1536 + p;
        else if (tile == 7) { if (bj == 0) sc = 1792 + p; else if (wc == 0) sc = 2176 + 16 * ((j >> 2) & 1) + 4 * (j >> 3) + (j & 3); else valid = false; }
        else sc = 1920 + p; }
    else if (KIND == WK_UQ) { const int tile = np >> 8, p = np & 255, bj = p >> 7, wc = (p & 127) >> 5, j = p & 31;
        if (bj == 0) sc = (2 * tile + (wc >> 1)) * 96 + 32 * (wc & 1) + j;
        else if (wc < 2) sc = (2 * tile + wc) * 96 + 64 + 16 * ((j >> 2) & 1) + 4 * (j >> 3) + (j & 3);
        else valid = false; }
    else if (KIND == WK_UKV) { if (np < 256) sc = (np >> 6) * 192 + (np & 63); else { const int q = np - 256; sc = (q >> 7) * 192 + 64 + (q & 127); } }
    float vv[32];
#pragma unroll
    for (int i = 0; i < 32; ++i) { const int k = k0 + 2 * i + (lane >> 5); const int ksrc = (KIND == WK_OUT) ? ((k + 512) & 1023) : k; vv[i] = valid ? src[(size_t)ksrc * Nsrc + sc] : 0.f; }
#pragma unroll
    for (int i = 0; i < 32; ++i) { const int kk = 2 * i + (lane >> 5), k = k0 + kk; float v = vv[i];
        if (KIND == WK_UQ || KIND == WK_UKV) v *= ks1[k];
        if (KIND == WK_OUT) v *= (k < 512) ? ks2[k] : ks1[(k - 512) & 127] * 0.8f;
        scr[kk * 33 + (lane & 31)] = v; }
    asm volatile("s_waitcnt lgkmcnt(0)" ::: "memory");
    const int c = lane & 7;
#pragma unroll
    for (int j = 0; j < 4; ++j) { const int n = (lane >> 3) + 8 * j; const LAS float* s = scr + (8 * c) * 33 + n;
        u32x4 o; o.x = pk2(s[0 * 33], s[1 * 33]); o.y = pk2(s[2 * 33], s[3 * 33]); o.z = pk2(s[4 * 33], s[5 * 33]); o.w = pk2(s[6 * 33], s[7 * 33]);
        *(u32x4*)(WT + (size_t)(n0 + n) * K + k0 + 8 * c) = o; }
    asm volatile("s_waitcnt lgkmcnt(0)" ::: "memory");
}

__device__ __forceinline__ void norm_mod_pass(const float* h, bf16_t* u, const float* modf, int slot_sh, int gw, int NGW, int lane, int nrows) {
    for (int row = gw; row < nrows; row += 2 * NGW) {
        const int row2 = row + NGW; const bool has2 = row2 < nrows;
        const f32x4* hr0 = (const f32x4*)(h + (size_t)row * DM) + lane; const f32x4* hr1 = (const f32x4*)(h + (size_t)(has2 ? row2 : row) * DM) + lane;
        f32x4 v0[4], v1[4]; float s0 = 0.f, s1 = 0.f;
#pragma unroll
        for (int j = 0; j < 4; ++j) { v0[j] = hr0[64 * j]; v1[j] = hr1[64 * j]; }
#pragma unroll
        for (int j = 0; j < 4; ++j) { s0 += (v0[j][0] * v0[j][0] + v0[j][1] * v0[j][1]) + (v0[j][2] * v0[j][2] + v0[j][3] * v0[j][3]); s1 += (v1[j][0] * v1[j][0] + v1[j][1] * v1[j][1]) + (v1[j][2] * v1[j][2] + v1[j][3] * v1[j][3]); }
        const float r0 = __builtin_amdgcn_rsqf(wave_sum(s0) * (1.f / DM) + NORM_EPS), r1 = __builtin_amdgcn_rsqf(wave_sum(s1) * (1.f / DM) + NORM_EPS);
#pragma unroll
        for (int q = 0; q < 2; ++q) { if (q == 1 && !has2) break;
            const int rw = q ? row2 : row; const int b = rw >> 11; const float rstd = q ? r1 : r0;
            const f32x4* ar = (const f32x4*)(modf + (size_t)b * NMOD + (slot_sh + 1) * DM) + lane;
            const f32x4* sr = (const f32x4*)(modf + (size_t)b * NMOD + slot_sh * DM) + lane;
            unsigned long long* o8 = (unsigned long long*)(u + (size_t)rw * DM) + lane;
#pragma unroll
            for (int j = 0; j < 4; ++j) { const f32x4 a = ar[64 * j], sh = sr[64 * j]; const f32x4 y = (q ? v1[j] : v0[j]) * rstd * a + sh;
                o8[64 * j] = (unsigned long long)pk2(y[0], y[1]) | ((unsigned long long)pk2(y[2], y[3]) << 32); } }
    }
}

#define XB_TMO      128
#define XB_XCNT(j)  (256  + 64 * (j))
#define XB_XSUB(j)  (1280 + 64 * (j))
#define XB_XGEN(j)  (2304 + 64 * (j))
#define XB_TOP      3328
#define XB_TOPGEN   3392
#define XCD_BAR_WORDS 3456
#define XB_SPIN_CAP (1u << 18)

__device__ __forceinline__ unsigned xb_ld(unsigned* p)              { return __hip_atomic_load(p, __ATOMIC_RELAXED, __HIP_MEMORY_SCOPE_AGENT); }
__device__ __forceinline__ unsigned xb_add(unsigned* p, unsigned v) { return __hip_atomic_fetch_add(p, v, __ATOMIC_RELAXED, __HIP_MEMORY_SCOPE_AGENT); }
__device__ __forceinline__ unsigned xb_xcc_id() { return (unsigned)__builtin_amdgcn_s_getreg((3 << 11) | 20) & 0xFu; }
#define XB_SPIN(cond, bar) do { unsigned _sp = 0; while (cond) { __builtin_amdgcn_s_sleep(1); \
    if ((++_sp & 255u) == 0u) { if (xb_ld(&(bar)[XB_TMO])) break; if (_sp > XB_SPIN_CAP) { atomicAdd(&(bar)[XB_TMO], 1u); break; } } } } while (0)

struct XcdBarrier {
    unsigned* bar; unsigned x; unsigned G;
    volatile LAS unsigned* st;
};

__device__ __forceinline__ XcdBarrier xcd_barrier_post(unsigned* bar, volatile LAS unsigned* st, const bool leader, const unsigned G) {
    XcdBarrier b; b.bar = bar; b.x = xb_xcc_id(); b.st = st; b.G = G;
    if (leader) (void)xb_add(&bar[XB_XCNT(b.x)], 1u);
    return b;
}
__device__ __forceinline__ void xcd_barrier_complete(unsigned* bar, unsigned x, const unsigned G, unsigned& nloc, unsigned& nx) {
    unsigned sum, cnt, mine, sp = 0u;
    for (;;) {
        sum = 0u; cnt = 0u; mine = 0u;
#pragma unroll
        for (unsigned j = 0; j < 16; ++j) { const unsigned c = xb_ld(&bar[XB_XCNT(j)]); sum += c; cnt += (c > 0u) ? 1u : 0u; mine = (j == x) ? c : mine; }
        if (sum == G) break;
        __builtin_amdgcn_s_sleep(1);
        if ((++sp & 255u) == 0u) { if (xb_ld(&bar[XB_TMO])) break; if (sp > XB_SPIN_CAP) { atomicAdd(&bar[XB_TMO], 1u); break; } }
    }
    nloc = mine > 0u ? mine : 1u; nx = cnt > 0u ? cnt : 1u;
}

__device__ __forceinline__ void xcd_barrier(const XcdBarrier& b, const bool leader) {
    asm volatile("s_waitcnt vmcnt(0)" ::: "memory");
    __syncthreads();
    if (leader) {
        unsigned* bar = b.bar;
        __builtin_amdgcn_s_waitcnt(0);
        unsigned nloc = b.st[0], nx = b.st[1];
        if (nloc == 0u) { xcd_barrier_complete(bar, b.x, b.G, nloc, nx); b.st[0] = nloc; b.st[1] = nx; }
        const unsigned old = xb_add(&bar[XB_XSUB(b.x)], 1u);
        const unsigned gen = old / nloc;
        if (old + 1u == (gen + 1u) * nloc) {
            __builtin_amdgcn_fence(__ATOMIC_RELEASE, "agent");
            asm volatile("s_waitcnt vmcnt(0)" ::: "memory");
            const unsigned og = xb_add(&bar[XB_TOP], 1u);
            const unsigned tg = og / nx;
            if (og + 1u == (tg + 1u) * nx) xb_add(&bar[XB_TOPGEN], 1u);
            else XB_SPIN(xb_ld(&bar[XB_TOPGEN]) == tg, bar);
            __builtin_amdgcn_fence(__ATOMIC_ACQUIRE, "agent");
            xb_add(&bar[XB_XGEN(b.x)], 1u);
            asm volatile("s_waitcnt vmcnt(0)" ::: "memory");
        } else {
            XB_SPIN(xb_ld(&bar[XB_XGEN(b.x)]) == gen, bar);
            __builtin_amdgcn_fence(__ATOMIC_ACQUIRE, "agent");
            asm volatile("s_waitcnt vmcnt(0)" ::: "memory");
        }
    }
    __syncthreads();
}

template <class Epi>
__device__ __forceinline__ void run_gemm(LAS unsigned char* lds, const bf16_t* A, const bf16_t* Bt, int N, int K, const Epi& E, const int tid) {
    pg8::Gemm g{A, Bt, M, N, K}; pg8::StaticOrder S; S.init(M, N, (int)gridDim.x, (int)blockIdx.x);
    pg8::gemm_phase<Epi, pg8::StaticOrder, true, GEMM_SP2>(lds, g, S, E, tid);
}

__global__ void __launch_bounds__(512) hymba_fwd(Args args) {
    extern __shared__ __attribute__((aligned(16))) unsigned char lds_raw[];
    LAS unsigned char* lds = (LAS unsigned char*)lds_raw;
    cg::grid_group grid = cg::this_grid();
    const int wid = __builtin_amdgcn_readfirstlane(threadIdx.x >> 6);
#define TID() ((wid << 6) | lane_id())
    const int G = gridDim.x, gw = blockIdx.x * 8 + wid, NGW = G * 8;
    { const int tid = TID(); volatile LAS unsigned* MISC0 = (volatile LAS unsigned*)(lds + MISC_OFF); if (tid < 32) MISC0[tid] = 0u; }
    unsigned char* ws = args.ws;
    volatile LAS unsigned* MISC = (volatile LAS unsigned*)(lds + MISC_OFF);
    __syncthreads();
    const int NISL = (G == 256) ? 8 : 1, isl = (int)blockIdx.x % NISL, GI = G / NISL, jblk = (int)blockIdx.x / NISL;
    const XcdBarrier xbar = xcd_barrier_post((unsigned*)(ws + WS_CTL) + 2048, MISC + 8, TID() == 0, (unsigned)G);
    const XcdBarrier ibar = xcd_barrier_post((unsigned*)(ws + WS_CTL) + 32768 + 4096 * isl, MISC + 10, TID() == 0, (unsigned)GI);
#define GSYNC_ALL() xcd_barrier(xbar, TID() == 0)
#define GSYNC() xcd_barrier(ibar, TID() == 0)
    const float* x = (const float*)args.in[0];
    float* out = args.out;
    float* modf = (float*)(ws + WS_MODF);
    float* COSD = (float*)(ws + WS_COSD); float* SIND = (float*)(ws + WS_SIND); float* COSR = (float*)(ws + WS_COSR); float* SINR = (float*)(ws + WS_SINR);
    float* SSCQ = (float*)(ws + WS_SSCQ); float* SSCKV = (float*)(ws + WS_SSCKV); float* SSOM = (float*)(ws + WS_SSOM);
    bf16_t* WGU1 = (bf16_t*)(ws + WS_WGU1); bf16_t* WD1 = (bf16_t*)(ws + WS_WD1); bf16_t* WGU2 = (bf16_t*)(ws + WS_WGU2); bf16_t* WD2 = (bf16_t*)(ws + WS_WD2);
    bf16_t* WIN = (bf16_t*)(ws + WS_WIN); bf16_t* WOUT = (bf16_t*)(ws + WS_WOUT); bf16_t* WUQ = (bf16_t*)(ws + WS_WUQ); bf16_t* WUKV = (bf16_t*)(ws + WS_WUKV);
    bf16_t* U = (bf16_t*)(ws + WS_U); bf16_t* HID = (bf16_t*)(ws + WS_HID);
    bf16_t* DQ = (bf16_t*)(ws + WS_DQ); bf16_t* DK = (bf16_t*)(ws + WS_DK); bf16_t* DV = (bf16_t*)(ws + WS_DV); bf16_t* CQ = (bf16_t*)(ws + WS_CQ); bf16_t* CKV = (bf16_t*)(ws + WS_CKV);
    bf16_t* KR = (bf16_t*)(ws + WS_KR); bf16_t* MQ = (bf16_t*)(ws + WS_MQ); bf16_t* MK = (bf16_t*)(ws + WS_MK); bf16_t* MV = (bf16_t*)(ws + WS_MV);
    bf16_t* ATT = U; bf16_t* U3 = (bf16_t*)(ws + WS_U3); bf16_t* HB = (bf16_t*)(ws + WS_HB);

    for (int rep0 = 0; rep0 < REP_P0; ++rep0) {
        const int tid = TID(), lane = tid & 63;
        if (REP_P0 > 1) __syncthreads();
        if (blockIdx.x < 144) {
            const float* c = (const float*)args.in[1]; const float* w_ada = (const float*)args.in[3]; const float* b_ada = (const float*)args.in[4];
            LAS float* cs = (LAS float*)lds; LAS float* red = (LAS float*)(lds + 65536);
            for (int i = tid; i < BATCH * DM; i += 512) { const float v = c[i]; cs[i] = v / (1.f + __expf(-v)); }
            __syncthreads();
            const int col = blockIdx.x * 64 + lane;
            float acc[16];
#pragma unroll
            for (int b = 0; b < 16; ++b) acc[b] = 0.f;
            const float* wp = w_ada + (size_t)(wid * 128) * NMOD + col;
            for (int k0 = 0; k0 < 128; k0 += 16) {
                float w[16];
#pragma unroll
                for (int j = 0; j < 16; ++j) w[j] = wp[(size_t)(k0 + j) * NMOD];
#pragma unroll
                for (int b = 0; b < 16; ++b) {
#pragma unroll
                    for (int q = 0; q < 4; ++q) { const f32x4 c4 = *(const LAS f32x4*)(cs + b * DM + wid * 128 + k0 + 4 * q);
                        acc[b] += (c4[0] * w[4 * q] + c4[1] * w[4 * q + 1]) + (c4[2] * w[4 * q + 2] + c4[3] * w[4 * q + 3]); } }
            }
#pragma unroll
            for (int b = 0; b < 16; ++b) red[(wid * 16 + b) * 64 + lane] = acc[b];
            __syncthreads();
            const int slot = (blockIdx.x * 64) >> 10;
            const float* gn = (slot == 1) ? (const float*)args.in[5] : (slot == 4) ? (const float*)args.in[9] : (const float*)args.in[22];
#pragma unroll
            for (int h = 0; h < 2; ++h) { const int b = (tid >> 6) + 8 * h; float s = 0.f;
#pragma unroll
                for (int w = 0; w < 8; ++w) s += red[(w * 16 + b) * 64 + lane];
                s += b_ada[col];
                if (slot == 1 || slot == 4 || slot == 7) s = gn[col & 1023] * (1.f + s);
                if (slot == 2 || slot == 8) s *= 0.5f;
                modf[(size_t)b * NMOD + col] = s; }
            __syncthreads();
        }
        if (blockIdx.x == 255 && tid == 0) {
            const float* q1 = (const float*)args.in[11]; const float* k1 = (const float*)args.in[12]; const float* q2 = (const float*)args.in[13]; const float* k2 = (const float*)args.in[14];
            float s1 = 0.f, s2 = 0.f;
            for (int i = 0; i < 64; ++i) { s1 += q1[i] * k1[i]; s2 += q2[i] * k2[i]; }
            *(float*)(ws + WS_LAM) = __expf(s1) - __expf(s2) + 0.2f;
        }
        { const int* pos = (const int*)args.in[2];
          const int gt = blockIdx.x * 512 + tid, NGT = G * 512;
          for (int i = gt; i < M * 32; i += NGT) { const int row = i >> 5, j = i & 31;
              const float inv = exp2f(-(float)(2 * j) * (13.287712379549449f / 64.f)); const float ang = (float)pos[row] * inv;
              const double rv = (double)ang * 0.15915494309189535; const float fr = (float)(rv - __builtin_rint(rv));
              COSD[i] = __builtin_amdgcn_cosf(fr); SIND[i] = __builtin_amdgcn_sinf(fr); }
          for (int i = gt; i < M * 16; i += NGT) { const int row = i >> 4, j = i & 15;
              const float inv = exp2f(-(float)(2 * j) * (13.287712379549449f / 32.f)); const float ang = (float)pos[row] * inv;
              const double rv = (double)ang * 0.15915494309189535; const float fr = (float)(rv - __builtin_rint(rv));
              COSR[i] = __builtin_amdgcn_cosf(fr); SINR[i] = __builtin_amdgcn_sinf(fr); } }
        { LAS float* scr = (LAS float*)(lds + wid * 16384);
          constexpr int I_GU = 16 * 176, I_D = 44 * 32, I_IN = 16 * 72, I_OUT = 16 * 32, I_UQ = 6 * 16, I_UKV = 4 * 24;
          constexpr int NITEMS = 2 * (I_GU + I_D) + I_IN + I_OUT + I_UQ + I_UKV;
          const int gwr = ((blockIdx.x + 112) & 255) * 8 + wid;
          for (int it = gwr; it < NITEMS; it += NGW) {
              int r = it;
              if (r < I_GU) { transpose_item<WK_GU>((const float*)args.in[6], (const float*)args.in[7], nullptr, nullptr, DM, DFF, 2 * DFF, WGU1, scr, r, lane); continue; } r -= I_GU;
              if (r < I_GU) { transpose_item<WK_GU>((const float*)args.in[23], (const float*)args.in[24], nullptr, nullptr, DM, DFF, 2 * DFF, WGU2, scr, r, lane); continue; } r -= I_GU;
              if (r < I_D) { transpose_item<WK_PLAIN>((const float*)args.in[8], nullptr, nullptr, nullptr, DFF, DM, DM, WD1, scr, r, lane); continue; } r -= I_D;
              if (r < I_D) { transpose_item<WK_PLAIN>((const float*)args.in[25], nullptr, nullptr, nullptr, DFF, DM, DM, WD2, scr, r, lane); continue; } r -= I_D;
              if (r < I_IN) { transpose_item<WK_IN>((const float*)args.in[10], nullptr, nullptr, nullptr, DM, 2208, 2304, WIN, scr, r, lane); continue; } r -= I_IN;
              if (r < I_OUT) { transpose_item<WK_OUT>((const float*)args.in[21], nullptr, (const float*)args.in[15], (const float*)args.in[20], DM, DM, DM, WOUT, scr, r, lane); continue; } r -= I_OUT;
              if (r < I_UQ) { transpose_item<WK_UQ>((const float*)args.in[17], nullptr, (const float*)args.in[16], nullptr, 384, 384, 512, WUQ, scr, r, lane); continue; } r -= I_UQ;
              transpose_item<WK_UKV>((const float*)args.in[19], nullptr, (const float*)args.in[18], nullptr, 256, 768, 768, WUKV, scr, r, lane);
          } }
    }
    if (args.use_cg) grid.sync(); else GSYNC_ALL();
    { const int rows_i = M / NISL; norm_mod_pass(x + (size_t)isl * rows_i * DM, U + (size_t)isl * rows_i * DM, modf + (size_t)(isl * (BATCH / NISL)) * NMOD, 0, jblk * 8 + wid, GI * 8, lane_id(), rows_i); }
    {
        const int lane = lane_id();
        float* CV1 = (float*)(ws + WS_CV1); float* CV2 = (float*)(ws + WS_CV2);
        const int nstep = GI * 8;
        for (int n0 = jblk * 8 + wid; n0 < 2304 + 2 * DFF; n0 += 4 * nstep) {
            u32x4 w0[4], w1[4];
#pragma unroll
            for (int q = 0; q < 4; ++q) { const int n = n0 + q * nstep, nn = (n < 2304 + 2 * DFF) ? n : n0; const bf16_t* wrow = (nn < 2304) ? (WIN + (size_t)nn * DM) : (WGU2 + (size_t)(nn - 2304) * DM);
                w0[q] = *(const u32x4*)(wrow + lane * 16); w1[q] = *(const u32x4*)(wrow + lane * 16 + 8); }
#pragma unroll
            for (int q = 0; q < 4; ++q) { const int n = n0 + q * nstep; if (n >= 2304 + 2 * DFF) break;
                const bool first = n < 2304; const int slot = first ? 3 : 6;
                float wf[16];
#pragma unroll
                for (int j = 0; j < 4; ++j) { wf[2 * j] = __uint_as_float(w0[q][j] << 16); wf[2 * j + 1] = __uint_as_float(w0[q][j] & 0xffff0000u); wf[8 + 2 * j] = __uint_as_float(w1[q][j] << 16); wf[9 + 2 * j] = __uint_as_float(w1[q][j] & 0xffff0000u); }
                for (int b = isl * (BATCH / NISL); b < (isl + 1) * (BATCH / NISL); ++b) {
                    const f32x4* sp = (const f32x4*)(modf + (size_t)b * NMOD + slot * DM + lane * 16);
                    float p = 0.f;
#pragma unroll
                    for (int j = 0; j < 4; ++j) { const f32x4 a = sp[j]; p += (a[0] * wf[4 * j] + a[1] * wf[4 * j + 1]) + (a[2] * wf[4 * j + 2] + a[3] * wf[4 * j + 3]); }
                    p = wave_sum(p);
                    if (lane == 0) { if (first) CV1[(size_t)b * 2304 + n] = p; else CV2[(size_t)b * (2 * DFF) + (n - 2304)] = p; }
                }
            }
        }
    }
    GSYNC();
    for (int rep = 0; rep < EXTRA_SYNC; ++rep) grid.sync();
#ifndef NO_SWI1
    for (int rep = 0; rep < REP_P2; ++rep) { pg8::EpiSwiGLU<false> E{HID, DFF, nullptr, nullptr}; run_gemm(lds, U, WGU1, 2 * DFF, DM, E, TID()); }
#endif
    GSYNC();
#ifndef NO_RES1
    for (int rep = 0; rep < REP_P3; ++rep) { pg8::EpiResidNorm<0, 0, 1> E{x, HB, modf, 2, 3, U, nullptr, (float*)(ws + WS_XBUF), (unsigned*)(ws + WS_PCNT), 32u * (unsigned)(rep + 1), lds + 131072, nullptr}; run_gemm(lds, HID, WD1, DM, DFF, E, TID()); }
#endif
    GSYNC();
#ifndef NO_PROJ
    for (int rep = 0; rep < REP_P5; ++rep) { pg8::EpiProj E{ws}; run_gemm(lds, U, WIN, 2304, DM, E, TID()); }
#endif
    GSYNC();
#ifndef NO_UQ
    for (int rep6 = 0; rep6 < REP_P6; ++rep6) { pg8::EpiUq E{ws}; run_gemm(lds, CQ, WUQ, 512, 384, E, TID()); }
#endif
#ifndef NO_UKV
    for (int rep6 = 0; rep6 < REP_P6; ++rep6) { pg8::EpiUkv E{ws}; run_gemm(lds, CKV, WUKV, 768, 256, E, TID()); }
#endif
    GSYNC();
#ifndef NO_ATT
    {
        unsigned* ctr = (unsigned*)(ws + WS_CTL) + 16 + 64 * isl;
        const int upc = 64 / NISL;
        const float lam = *(const float*)(ws + WS_LAM);
        for (;;) {
            int tid_a = TID(); asm volatile("" : "+v"(tid_a));
            const int tid = tid_a, lane = tid & 63;
            const int r32 = lane & 31, hi = lane >> 5;
            unsigned mo_ = MISC_OFF; asm volatile("" : "+s"(mo_));
            volatile LAS unsigned* misc = (volatile LAS unsigned*)(lds + mo_);
            if (tid == 0) misc[0] = atomicAdd(ctr, 1u);
            __syncthreads();
            const unsigned ui = misc[0];
            __syncthreads();
            if (ui >= (unsigned)(16 * upc) * REP_ATT) break;
            const unsigned long long order = 0x7654FE3D2CB1A908ull;
            const int uu = (int)(ui % (unsigned)(16 * upc)), cls = uu / upc, rem = uu % upc, code = (int)((order >> (4 * (15 - cls))) & 15ull);
            const int mla = code >> 3, qb = code & 7, b = isl * (BATCH / NISL) + (rem >> 2), h = rem & 3;
            const int q0 = qb * 256; const size_t rb = (size_t)b * SEQ;
            att::f32x16 o[4]; float l;
            const int myrow = q0 + wid * 32 + r32;
            bf16_t* orow = ATT + (rb + myrow) * DM + (mla ? 0 : 512) + h * 128 + 4 * hi;
#ifdef T_NOMLA
            if (false) {
#elif defined(T_NODIFF)
            if (true) {
#else
            if (mla) {
#endif
                att::PassArgs pa{MQ + rb * 384 + h * 96, 384, MK + rb * 256 + h * 64, 256, KR + rb * 32, 32, MV + rb * 512 + h * 128, 512};
                att::flash_pass<96>(o, l, pa, q0, lds, tid, wid, lane);
                const float il = 1.f / l; float ss = 0.f;
#pragma unroll
                for (int db = 0; db < 4; ++db)
#pragma unroll
                    for (int r = 0; r < 16; ++r) { o[db][r] *= il; ss += o[db][r] * o[db][r]; }
                ss += __shfl_xor(ss, 32);
                if (hi == 0) SSOM[(rb + myrow) * 4 + h] = ss;
#pragma unroll
                for (int db = 0; db < 4; ++db)
#pragma unroll
                    for (int g = 0; g < 4; ++g) { u32x2 w; w.x = att::cvtpk(o[db][4 * g], o[db][4 * g + 1]); w.y = att::cvtpk(o[db][4 * g + 2], o[db][4 * g + 3]); *(u32x2*)(orow + 32 * db + 8 * g) = w; }
            } else {
                LAS unsigned* oast = (LAS unsigned*)(lds + 61440) + wid * 2048 + lane;
                for (int mp = 0; mp < 2; ++mp) {
                    att::PassArgs pa{DQ + rb * 512 + (2 * h + mp) * 64, 512, DK + rb * 512 + (2 * h + mp) * 64, 512, nullptr, 0, DV + rb * 512 + h * 128, 512};
                    att::flash_pass<64>(o, l, pa, q0, lds, tid, wid, lane);
                    const float il = 1.f / l;
                    if (mp == 0) {
#pragma unroll
                        for (int db = 0; db < 4; ++db)
#pragma unroll
                            for (int j = 0; j < 8; ++j) oast[(db * 8 + j) * 64] = att::cvtpk(o[db][2 * j] * il, o[db][2 * j + 1] * il);
                    } else {
                        float ss = 0.f; const float c2 = lam * il;
#pragma unroll
                        for (int db = 0; db < 4; ++db)
#pragma unroll
                            for (int j = 0; j < 8; ++j) { const unsigned w = oast[(db * 8 + j) * 64]; const float a0 = __uint_as_float(w << 16), a1 = __uint_as_float(w & 0xffff0000u);
                                const float d0 = a0 - c2 * o[db][2 * j], d1 = a1 - c2 * o[db][2 * j + 1]; o[db][2 * j] = d0; o[db][2 * j + 1] = d1; ss += d0 * d0 + d1 * d1; }
                        ss += __shfl_xor(ss, 32);
                        const float rstd = __builtin_amdgcn_rsqf(ss * (1.f / 128.f) + NORM_EPS);
#pragma unroll
                        for (int db = 0; db < 4; ++db)
#pragma unroll
                            for (int g = 0; g < 4; ++g) { u32x2 w; w.x = att::cvtpk(o[db][4 * g] * rstd, o[db][4 * g + 1] * rstd); w.y = att::cvtpk(o[db][4 * g + 2] * rstd, o[db][4 * g + 3] * rstd); *(u32x2*)(orow + 32 * db + 8 * g) = w; }
                    }
                }
            }
        }
    }
#endif
    GSYNC();
#ifndef NO_RES2
    { pg8::EpiResidNorm<0, 1, 1, true> E{HB, HB, modf, 5, 6, U3, nullptr, (float*)(ws + WS_XBUF), (unsigned*)(ws + WS_PCNT), 32u * REP_P3 + 32u, lds + 131072, SSOM}; run_gemm(lds, ATT, WOUT, DM, DM, E, TID()); }
#endif
    GSYNC();
#ifndef NO_SWI2
    { pg8::EpiSwiGLU<true> E{HID, DFF, (const float*)(ws + WS_XBUF), (const float*)(ws + WS_CV2)}; run_gemm(lds, U3, WGU2, 2 * DFF, DM, E, TID()); }
#endif
    GSYNC();
#ifndef NO_RES3
    { pg8::EpiResidNorm<1, 1, 0> E{HB, out, modf, 8, 0, nullptr, (const float*)args.in[26], (float*)(ws + WS_XBUF), (unsigned*)(ws + WS_PCNT), 32u, lds + 131072, nullptr}; run_gemm(lds, HID, WD2, DM, DFF, E, TID()); }
#endif
}

extern "C" void kernel_launch(void* const* d_in, const int* in_sizes, int n_in, void* d_out, int out_size, void* d_ws, size_t ws_size, hipStream_t stream) {
    static int grid_blocks = 0;
    if (grid_blocks == 0) {
        if (n_in != 27 || out_size != M * DM || ws_size < WS_END) { fprintf(stderr, "kernel_launch: unexpected shapes (n_in %d, out %d, ws %zu)\n", n_in, out_size, ws_size); grid_blocks = -1; return; }
        int dev = 0, cus = 0, per_cu = 0;
        hipGetDevice(&dev);
        hipDeviceGetAttribute(&cus, hipDeviceAttributeMultiprocessorCount, dev);
        if (hipFuncSetAttribute((const void*)hymba_fwd, hipFuncAttributeMaxDynamicSharedMemorySize, LDS_BYTES) != hipSuccess) { fprintf(stderr, "kernel_launch: hipFuncSetAttribute failed\n"); grid_blocks = -1; return; }
        if (hipOccupancyMaxActiveBlocksPerMultiprocessor(&per_cu, (const void*)hymba_fwd, 512, LDS_BYTES) != hipSuccess || per_cu < 1) { fprintf(stderr, "kernel_launch: occupancy query failed (%d)\n", per_cu); (void)hipGetLastError(); per_cu = 1; }
        grid_blocks = cus * per_cu;
    }
    if (grid_blocks < 0) return;
    (void)hipMemsetAsync((char*)d_ws + WS_CTL, 0, 262144, stream);
    Args a{};
    for (int i = 0; i < 27; ++i) a.in[i] = d_in[i];
    a.out = (float*)d_out; a.ws = (unsigned char*)d_ws; a.use_cg = 0ull;
    void* kargs[] = {&a};
    hipError_t e = hipLaunchCooperativeKernel((const void*)hymba_fwd, dim3(grid_blocks), dim3(512), kargs, LDS_BYTES, stream);
    if (e != hipSuccess) fprintf(stderr, "cooperative launch failed: %s (grid %d)\n", hipGetErrorString(e), grid_blocks);
}
```

```cpp
#include <hip/hip_runtime.h>
#include <hip/hip_cooperative_groups.h>
#include <cstdio>
#include <cstdint>
namespace cg = cooperative_groups;
namespace pg8 {
#define PG8_LAS __attribute__((address_space(3)))
typedef unsigned short bf16_t;
typedef short bf16x8 __attribute__((ext_vector_type(8)));
typedef float f32x4 __attribute__((ext_vector_type(4)));
typedef unsigned u32x4 __attribute__((ext_vector_type(4)));
constexpr int BM = 256, BK = 64, HALF = 128, HTB = HALF * BK * 2  , STAGE_BYTES = 8 * HTB, NXCD = 8, WGM = 8;

__host__ __device__ __forceinline__ int lds_byte(int r, int c) { const int st = (r >> 4) * 2 + (c >> 5), rr = r & 15, cc = c & 31, ob = rr * 64 + cc * 2; return st * 1024 + (ob ^ (((ob >> 9) & 1) << 5)); }
__host__ __device__ __forceinline__ void stage_rc(int b, int& R, int& C) { const int st = b / 1024, sb = b % 1024, swz = sb ^ (((sb >> 9) & 1) << 5); R = (st >> 1) * 16 + swz / 64; C = (st & 1) * 32 + (swz % 64) / 2; }
__host__ __device__ __forceinline__ int perm32(int rho) { const int n = rho >> 4, i = rho & 15; return 8 * (i >> 2) + 4 * n + (i & 3); }

struct Unit { int pm, pn; };
struct Gemm { const bf16_t* A; const bf16_t* Bt; int M, N, K; };

struct StaticOrder {
    int nM, nN, nwg, G, c;
    __host__ __device__ void init(int M, int N, int G_, int c_) { nM = M / BM; nN = N / BM; nwg = nM * nN; G = G_; c = c_; }
    __host__ __device__ bool next(int i, Unit& u) const {
        const long L = (long)i * G + c; if (L >= nwg) return false;
        int wgid = (int)L; { const int q = nwg / NXCD, r = nwg % NXCD, xcd = wgid % NXCD, off = wgid / NXCD; wgid = (xcd < r ? xcd * (q + 1) : r * (q + 1) + (xcd - r) * q) + off; }
        const int nig = WGM * nN, gid = wgid / nig, fm = gid * WGM, gsz = (nM - fm) < WGM ? (nM - fm) : WGM;
        u.pm = fm + ((wgid % nig) % gsz); u.pn = (wgid % nig) / gsz; return true;
    }
    __device__ __forceinline__ void a_ready(const Unit&) const {}
    __device__ __forceinline__ void done(const Unit&) const {}
};

__device__ __forceinline__ unsigned cvt_pk_bf16(float lo, float hi) { unsigned r; asm volatile("v_cvt_pk_bf16_f32 %0, %1, %2" : "=v"(r) : "v"(lo), "v"(hi)); return r; }
typedef float f32x2 __attribute__((ext_vector_type(2)));
template <class Epi, class Sched, bool ALIGN_EPI = false, bool SP2 = false>
__device__ __forceinline__ void gemm_phase(PG8_LAS unsigned char* lds, const Gemm g, const Sched& S, const Epi& E, const int tid_in) {
    int tid_ = tid_in; asm volatile("" : "+v"(tid_)); const int tid = tid_, wid = __builtin_amdgcn_readfirstlane(tid >> 6), lane = tid & 63, wr = wid >> 2, wc = wid & 3, fr = lane & 15, fq = lane >> 4;
    const int K = g.K, nt = K / BK;
    unsigned voffA[2], voffB[2];
#pragma unroll
    for (int i = 0; i < 2; ++i) { int R, C; stage_rc(tid * 16 + i * 8192, R, C); const int Rb = Epi::PERM ? ((R & ~31) + perm32(R & 31)) : R;
        voffA[i] = (unsigned)(R * K + C) * 2u; voffB[i] = (unsigned)(Rb * K + C) * 2u; }
    const size_t kstep = (size_t)(BK * 2);
    const size_t hstep = (size_t)HALF * K * 2;
    const size_t tstep = 2 * hstep;
    const unsigned ldsw = (unsigned)wid * 1024u;
    const int aoff = lds_byte(wr * 64 + fr, fq * 8), boff = lds_byte(wc * 32 + fr, fq * 8);
#define PG8_SA(b, h) (((b) * 2 + (h)) * HTB)
#define PG8_SB(b, h) ((4 + (b) * 2 + (h)) * HTB)
#define PG8_STAGE(bufoff, gbase, voff) do { _Pragma("unroll") for (int _i = 0; _i < 2; ++_i) \
        __builtin_amdgcn_global_load_lds((const unsigned*)((const char*)(gbase) + (voff)[_i]), (PG8_LAS unsigned*)(lds + (bufoff) + ldsw + _i * 8192), 16, 0, 0); } while (0)
#define PG8_LDA(dst, b, h) do { _Pragma("unroll") for (int m = 0; m < 4; ++m) _Pragma("unroll") for (int k = 0; k < 2; ++k) dst[m][k] = *(const PG8_LAS bf16x8*)(lds + PG8_SA(b, h) + aoff + m * 2048 + k * 1024); } while (0)
#define PG8_LDB(dst, b, h) do { _Pragma("unroll") for (int n = 0; n < 2; ++n) _Pragma("unroll") for (int k = 0; k < 2; ++k) dst[n][k] = *(const PG8_LAS bf16x8*)(lds + PG8_SB(b, h) + boff + n * 2048 + k * 1024); } while (0)
#define PG8_MMA(ai, bj, At, Bt) do { __builtin_amdgcn_s_setprio(1); _Pragma("unroll") for (int m = 0; m < 4; ++m) _Pragma("unroll") for (int n = 0; n < 2; ++n) _Pragma("unroll") for (int k = 0; k < 2; ++k) \
        acc[ai][bj][m][n] = __builtin_amdgcn_mfma_f32_16x16x32_bf16(Bt[n][k], At[m][k], acc[ai][bj][m][n], 0, 0, 0); __builtin_amdgcn_s_setprio(0); } while (0)
#define PG8_WAIT_V(n) asm volatile("s_waitcnt vmcnt(" #n ")" ::: "memory")
#define PG8_WAIT_L(n) asm volatile("s_waitcnt lgkmcnt(" #n ")" ::: "memory")
#define PG8_BAR __builtin_amdgcn_s_barrier()
#define PG8_SCHED __builtin_amdgcn_sched_barrier(0)
    Unit cur, nxt; int ui = 0;
    if (!S.next(0, cur)) return;
    f32x4 acc[2][2][4][2];
#pragma unroll
    for (int a = 0; a < 2; ++a)
#pragma unroll
        for (int b = 0; b < 2; ++b)
#pragma unroll
            for (int m = 0; m < 4; ++m)
#pragma unroll
                for (int n = 0; n < 2; ++n) acc[a][b][m][n] = (f32x4){0.f, 0.f, 0.f, 0.f};
    bf16x8 At[4][2], B0[2][2], B1[2][2];
    const char* cA = (const char*)g.A + (size_t)cur.pm * tstep; const char* cB = (const char*)g.Bt + (size_t)cur.pn * tstep;
    S.a_ready(cur);
    if constexpr (SP2) {
        PG8_STAGE(PG8_SB(0, 0), cB, voffB); PG8_STAGE(PG8_SB(0, 1), cB + hstep, voffB); PG8_STAGE(PG8_SA(0, 0), cA, voffA); PG8_STAGE(PG8_SA(0, 1), cA + hstep, voffA);
        if (wr == 1) PG8_BAR;
        PG8_WAIT_V(2); PG8_BAR;
        PG8_STAGE(PG8_SB(1, 0), cB + kstep, voffB); PG8_STAGE(PG8_SA(1, 0), cA + kstep, voffA); PG8_STAGE(PG8_SB(1, 1), cB + hstep + kstep, voffB);
        PG8_WAIT_V(6); PG8_BAR;
    } else {
        PG8_STAGE(PG8_SB(0, 0), cB, voffB); PG8_STAGE(PG8_SA(0, 0), cA, voffA); PG8_STAGE(PG8_SB(0, 1), cB + hstep, voffB); PG8_STAGE(PG8_SA(0, 1), cA + hstep, voffA);
        if (wr == 1) PG8_BAR;
        PG8_WAIT_V(4); PG8_BAR;
        PG8_STAGE(PG8_SB(1, 0), cB + kstep, voffB); PG8_STAGE(PG8_SA(1, 0), cA + kstep, voffA); PG8_STAGE(PG8_SB(1, 1), cB + hstep + kstep, voffB);
        PG8_WAIT_V(6); PG8_BAR;
    }
    for (;;) {
        const bool has_next = S.next(ui + 1, nxt);
        const char* nA = has_next ? (const char*)g.A + (size_t)nxt.pm * tstep : cA; const char* nB = has_next ? (const char*)g.Bt + (size_t)nxt.pn * tstep : cB;
        _Pragma("nounroll") for (int t = 0; t < nt; t += 2) {
            if constexpr (Epi::MIDK) { if (t == 8) E.midk(acc, cur, wr, fr); }
            const bool last = (t == nt - 2);
            const char* a1 = cA + (size_t)(t + 1) * kstep;
            const char* a2 = last ? nA : cA + (size_t)(t + 2) * kstep; const char* b2 = last ? nB : cB + (size_t)(t + 2) * kstep;
            const char* a3 = a2 + kstep; const char* b3 = b2 + kstep;
            if (last && has_next) S.a_ready(nxt);
            if constexpr (SP2) {
            PG8_LDB(B0, 0, 0); PG8_LDB(B1, 0, 1); PG8_SCHED; PG8_LDA(At, 0, 0); PG8_STAGE(PG8_SA(1, 1), a1 + hstep, voffA);
            PG8_WAIT_V(8); PG8_WAIT_L(0); PG8_BAR; PG8_MMA(0, 0, At, B0); PG8_MMA(0, 1, At, B1); PG8_BAR; PG8_SCHED;
            PG8_LDA(At, 0, 1); PG8_STAGE(PG8_SB(0, 0), b2, voffB); PG8_STAGE(PG8_SB(0, 1), b2 + hstep, voffB); PG8_STAGE(PG8_SA(0, 0), a2, voffA);
            PG8_WAIT_V(8); PG8_WAIT_L(0); PG8_BAR; PG8_MMA(1, 0, At, B0); PG8_MMA(1, 1, At, B1); PG8_BAR; PG8_SCHED;
            PG8_LDB(B0, 1, 0); PG8_LDB(B1, 1, 1); PG8_SCHED; PG8_LDA(At, 1, 0); PG8_STAGE(PG8_SA(0, 1), a2 + hstep, voffA);
            PG8_WAIT_V(8); PG8_WAIT_L(0); PG8_BAR; PG8_MMA(0, 0, At, B0); PG8_MMA(0, 1, At, B1); PG8_BAR; PG8_SCHED;
            PG8_LDA(At, 1, 1); PG8_STAGE(PG8_SB(1, 0), b3, voffB); PG8_STAGE(PG8_SB(1, 1), b3 + hstep, voffB); PG8_STAGE(PG8_SA(1, 0), a3, voffA);
            PG8_WAIT_V(8); PG8_WAIT_L(0); PG8_BAR; PG8_MMA(1, 0, At, B0); PG8_MMA(1, 1, At, B1); PG8_BAR; PG8_SCHED;
            } else {
            PG8_LDB(B0, 0, 0); PG8_SCHED; PG8_LDA(At, 0, 0); PG8_STAGE(PG8_SA(1, 1), a1 + hstep, voffA);
            PG8_WAIT_L(8); PG8_BAR; PG8_WAIT_L(0); PG8_MMA(0, 0, At, B0); PG8_BAR; PG8_SCHED;
            PG8_LDB(B1, 0, 1); PG8_STAGE(PG8_SB(0, 0), b2, voffB);
            PG8_BAR; PG8_WAIT_L(0); PG8_MMA(0, 1, At, B1); PG8_BAR;
            PG8_LDA(At, 0, 1); PG8_STAGE(PG8_SA(0, 0), a2, voffA);
            PG8_BAR; PG8_WAIT_L(0); PG8_MMA(1, 0, At, B0); PG8_BAR; PG8_SCHED;
            PG8_STAGE(PG8_SB(0, 1), b2 + hstep, voffB);
            PG8_WAIT_V(6); PG8_BAR; PG8_MMA(1, 1, At, B1); PG8_BAR;
            PG8_LDB(B0, 1, 0); PG8_SCHED; PG8_LDA(At, 1, 0); PG8_STAGE(PG8_SA(0, 1), a2 + hstep, voffA);
            PG8_WAIT_L(8); PG8_BAR; PG8_WAIT_L(0); PG8_MMA(0, 0, At, B0); PG8_BAR; PG8_SCHED;
            PG8_LDB(B1, 1, 1); PG8_STAGE(PG8_SB(1, 0), b3, voffB);
            PG8_BAR; PG8_WAIT_L(0); PG8_MMA(0, 1, At, B1); PG8_BAR;
            PG8_LDA(At, 1, 1); PG8_STAGE(PG8_SA(1, 0), a3, voffA);
            PG8_BAR; PG8_WAIT_L(0); PG8_MMA(1, 0, At, B0); PG8_BAR; PG8_SCHED;
            PG8_STAGE(PG8_SB(1, 1), b3 + hstep, voffB);
            PG8_WAIT_V(6); PG8_BAR; PG8_MMA(1, 1, At, B1); PG8_BAR;
            }
        }
        if constexpr (ALIGN_EPI) { if (wr == 0) PG8_BAR; }
        if constexpr (!Epi::AFTER_DRAIN) { E(acc, cur, wr, wc, fr, fq); S.done(cur); }
        if (!has_next) break;
#pragma unroll
        for (int a = 0; a < 2; ++a)
#pragma unroll
            for (int b = 0; b < 2; ++b)
#pragma unroll
                for (int m = 0; m < 4; ++m)
#pragma unroll
                    for (int n = 0; n < 2; ++n) acc[a][b][m][n] = (f32x4){0.f, 0.f, 0.f, 0.f};
        cur = nxt; cA = nA; cB = nB; ++ui;
        if constexpr (ALIGN_EPI) { if (wr == 1) PG8_BAR; }
    }
    PG8_WAIT_V(0);
    if constexpr (!ALIGN_EPI) { if (wr == 0) PG8_BAR; }
    PG8_BAR;
    if constexpr (Epi::AFTER_DRAIN) { E.fused(acc, cur, wr, wc, fr, fq, lds, wid, lane); S.done(cur); }
#undef PG8_SA
#undef PG8_SB
#undef PG8_STAGE
#undef PG8_LDA
#undef PG8_LDB
#undef PG8_MMA
#undef PG8_WAIT_V
#undef PG8_WAIT_L
#undef PG8_BAR
#undef PG8_SCHED
}
}

#ifndef REP_ATT
#define REP_ATT 1
#endif
#ifndef REP_P2
#define REP_P2 1
#endif
#ifndef REP_P1
#define REP_P1 1
#endif
#ifndef REP_P3
#define REP_P3 1
#endif
#ifndef REP_P5
#define REP_P5 1
#endif
#ifndef REP_P0
#define REP_P0 1
#endif
#ifndef GEMM_SP2
#define GEMM_SP2 true
#endif
#ifndef REP_P6
#define REP_P6 1
#endif
#ifndef EXTRA_SYNC
#define EXTRA_SYNC 0
#endif
constexpr int BATCH = 16, SEQ = 2048, DM = 1024, M = BATCH * SEQ, DFF = 2816, NMOD = 9 * DM;
constexpr float NORM_EPS = 1e-6f;
constexpr float LOG2E = 1.4426950408889634f;
constexpr float QSC_DIFF = 0.125f * LOG2E;
constexpr float QSC_MLA = 0.10206207261596577f * LOG2E;

constexpr size_t MiB = 1u << 20;
constexpr size_t WS_CTL = 0, WS_LAM = 4096, WS_MODF = 1 * MiB, WS_COSD = 2 * MiB, WS_SIND = 6 * MiB, WS_COSR = 10 * MiB, WS_SINR = 12 * MiB;
constexpr size_t WS_SSCQ = 14 * MiB, WS_SSCKV = 15 * MiB, WS_SSOM = 15 * MiB + 512 * 1024;
constexpr size_t WS_WGU1 = 16 * MiB, WS_WD1 = 27 * MiB, WS_WGU2 = 33 * MiB, WS_WD2 = 44 * MiB, WS_WIN = 50 * MiB, WS_WOUT = 55 * MiB, WS_WUQ = 57 * MiB, WS_WUKV = 58 * MiB;
constexpr size_t WS_U = 64 * MiB, WS_HID = 128 * MiB;
constexpr size_t WS_DQ = 128 * MiB, WS_DK = 160 * MiB, WS_DV = 192 * MiB, WS_CQ = 224 * MiB, WS_CKV = 248 * MiB, WS_KR = 264 * MiB, WS_MQ = 266 * MiB, WS_MK = 290 * MiB, WS_MV = 306 * MiB;
constexpr size_t WS_CV1 = 61 * MiB, WS_CV2 = 62 * MiB, WS_U3 = 338 * MiB, WS_HB = 402 * MiB, WS_END = 466 * MiB, WS_XBUF = 59 * MiB, WS_PCNT = 65536;
static_assert(WS_HID + (size_t)M * DFF * 2 <= WS_END && WS_MV + (size_t)M * 512 * 2 <= WS_END, "ws map");


__device__ __forceinline__ int lane_id() { int l; asm volatile("v_mbcnt_lo_u32_b32 %0, -1, 0\n\tv_mbcnt_hi_u32_b32 %0, -1, %0" : "=v"(l)); return l; }
namespace pg8 {
typedef unsigned u32x2 __attribute__((ext_vector_type(2)));
__device__ __forceinline__ u32x4 pack8(const f32x4 a, const f32x4 b) { u32x4 w; w.x = cvt_pk_bf16(a[0], a[1]); w.y = cvt_pk_bf16(a[2], a[3]); w.z = cvt_pk_bf16(b[0], b[1]); w.w = cvt_pk_bf16(b[2], b[3]); return w; }
__device__ __forceinline__ u32x2 pack4(const f32x4 a) { u32x2 w; w.x = cvt_pk_bf16(a[0], a[1]); w.y = cvt_pk_bf16(a[2], a[3]); return w; }
__device__ __forceinline__ float silu_f(float g) { return g * __builtin_amdgcn_rcpf(1.f + __builtin_amdgcn_exp2f(-LOG2E * g)); }
__device__ __forceinline__ float sumsq4(const f32x4 a) { return (a[0] * a[0] + a[1] * a[1]) + (a[2] * a[2] + a[3] * a[3]); }

__device__ __forceinline__ void deferred_norm_fixup(f32x4 (&acc)[2][2][4][2], const Unit& u, int wr, int wc, int fr, int fq, const float* ssh, const float* cv, int ncols) {
    const int row0 = u.pm * BM + wr * 64 + fr;
    const float* cb = cv + (size_t)(u.pm >> 3) * ncols + u.pn * BM + wc * 32 + 8 * fq;
    f32x4 c[2][2];
#pragma unroll
    for (int bj = 0; bj < 2; ++bj)
#pragma unroll
        for (int n = 0; n < 2; ++n) c[bj][n] = *(const f32x4*)(cb + bj * HALF + n * 4);
#pragma unroll
    for (int ai = 0; ai < 2; ++ai)
#pragma unroll
        for (int m = 0; m < 4; ++m) {
            const f32x4 st = *(const f32x4*)(ssh + (size_t)(row0 + ai * HALF + m * 16) * 4);
            const float r = __builtin_amdgcn_rsqf(((st[0] + st[1]) + (st[2] + st[3])) * (1.f / DM) + NORM_EPS);
#pragma unroll
            for (int bj = 0; bj < 2; ++bj)
#pragma unroll
                for (int n = 0; n < 2; ++n) acc[ai][bj][m][n] = acc[ai][bj][m][n] * r + c[bj][n];
            if (m == 3) asm volatile("" ::: "memory");
        }
}
template <bool DEFER> struct EpiSwiGLU {
    static constexpr bool PERM = true, AFTER_DRAIN = false, MIDK = false;
    bf16_t* O; int ldc; const float* ssh; const float* cv;
    __device__ __forceinline__ void operator()(f32x4 (&acc)[2][2][4][2], const Unit& u, int wr, int wc, int fr, int fq) const {
        if (DEFER) deferred_norm_fixup(acc, u, wr, wc, fr, fq, ssh, cv, 2 * DFF);
        const int row0 = u.pm * BM + wr * 64 + fr, col0 = u.pn * HALF + wc * 32 + 8 * fq;
#pragma unroll
        for (int ai = 0; ai < 2; ++ai)
#pragma unroll
            for (int m = 0; m < 4; ++m) {
                bf16_t* rowp = O + (size_t)(row0 + ai * HALF + m * 16) * ldc + col0;
                f32x4 h0, h1;
#pragma unroll
                for (int i = 0; i < 4; ++i) { h0[i] = silu_f(acc[ai][0][m][0][i]) * acc[ai][1][m][0][i]; h1[i] = silu_f(acc[ai][0][m][1][i]) * acc[ai][1][m][1][i]; }
                *(u32x4*)rowp = pack8(h0, h1);
            }
    }
};
struct EpiResid {
    static constexpr bool PERM = false, AFTER_DRAIN = false, MIDK = false;
    const float* base; float* out; const float* gate;
    __device__ __forceinline__ void operator()(const f32x4 (&acc)[2][2][4][2], const Unit& u, int wr, int wc, int fr, int fq) const {
        const int row0 = u.pm * BM + wr * 64 + fr, col0 = u.pn * BM + wc * 32 + 4 * fq;
        const float* gv = gate + (size_t)(u.pm >> 3) * NMOD + col0;
        f32x4 g[2][2];
#pragma unroll
        for (int bj = 0; bj < 2; ++bj)
#pragma unroll
            for (int n = 0; n < 2; ++n) g[bj][n] = *(const f32x4*)(gv + bj * HALF + n * 16);
#pragma unroll
        for (int ai = 0; ai < 2; ++ai)
#pragma unroll
            for (int m = 0; m < 4; ++m) {
                const size_t off = (size_t)(row0 + ai * HALF + m * 16) * DM + col0;
#pragma unroll
                for (int bj = 0; bj < 2; ++bj)
#pragma unroll
                    for (int n = 0; n < 2; ++n) { const f32x4 b = *(const f32x4*)(base + off + bj * HALF + n * 16); *(f32x4*)(out + off + bj * HALF + n * 16) = b + g[bj][n] * acc[ai][bj][m][n]; }
            }
    }
};
template <int FINAL, int BASE_BF16, int OUT_BF16, bool MIDK_ = false> struct EpiResidNorm {
    static constexpr bool PERM = true, AFTER_DRAIN = false, MIDK = MIDK_;
    const void* base_; void* out_; const float* modf; int gslot, sslot; bf16_t* U; const float* fn; float* xbuf; unsigned* cnt; unsigned want; PG8_LAS unsigned char* ldsx; const float* ssq;
    __device__ __forceinline__ void midk(f32x4 (&acc)[2][2][4][2], const Unit& u, int wr, int fr) const {
#pragma unroll
        for (int ai = 0; ai < 2; ++ai)
#pragma unroll
            for (int m = 0; m < 4; ++m) { const f32x4 s4 = *(const f32x4*)(ssq + (size_t)(u.pm * BM + ai * HALF + wr * 64 + m * 16 + fr) * 4);
                const float r = __builtin_amdgcn_rsqf(((s4[0] + s4[1]) + (s4[2] + s4[3])) * (1.f / 512.f) + NORM_EPS);
#pragma unroll
                for (int bj = 0; bj < 2; ++bj)
#pragma unroll
                    for (int n = 0; n < 2; ++n) acc[ai][bj][m][n] = acc[ai][bj][m][n] * r; }
    }
    __device__ __forceinline__ void operator()(f32x4 (&acc)[2][2][4][2], const Unit& u, int wr, int wc, int fr, int fq) const {
        const int row0 = u.pm * BM + wr * 64 + fr, col0 = u.pn * BM + wc * 32 + 8 * fq, rt0 = wr * 64 + fr;
        const float* mb = modf + (size_t)(u.pm >> 3) * NMOD + col0;
        if (!FINAL) {
            f32x4 g[2][2], av[2][2];
#pragma unroll
            for (int bj = 0; bj < 2; ++bj)
#pragma unroll
                for (int n = 0; n < 2; ++n) { g[bj][n] = *(const f32x4*)(mb + gslot * DM + bj * HALF + n * 4); av[bj][n] = *(const f32x4*)(mb + (sslot + 1) * DM + bj * HALF + n * 4); }
#pragma unroll
            for (int ai = 0; ai < 2; ++ai)
#pragma unroll
                for (int m = 0; m < 4; ++m) { const size_t off = (size_t)(row0 + ai * HALF + m * 16) * DM + col0; float ss = 0.f;
#pragma unroll
                    for (int bj = 0; bj < 2; ++bj) { f32x4 b0, b1;
                        if (BASE_BF16) { const u32x4 w = *(const u32x4*)((const bf16_t*)base_ + off + bj * HALF);
                            b0 = (f32x4){__uint_as_float(w.x << 16), __uint_as_float(w.x & 0xffff0000u), __uint_as_float(w.y << 16), __uint_as_float(w.y & 0xffff0000u)};
                            b1 = (f32x4){__uint_as_float(w.z << 16), __uint_as_float(w.z & 0xffff0000u), __uint_as_float(w.w << 16), __uint_as_float(w.w & 0xffff0000u)}; }
                        else { b0 = *(const f32x4*)((const float*)base_ + off + bj * HALF); b1 = *(const f32x4*)((const float*)base_ + off + bj * HALF + 4); }
                        const f32x4 h0 = b0 + g[bj][0] * acc[ai][bj][m][0], h1 = b1 + g[bj][1] * acc[ai][bj][m][1];
                        ss += sumsq4(h0) + sumsq4(h1);
                        *(u32x4*)((bf16_t*)out_ + off + bj * HALF) = pack8(h0, h1);
                        *(u32x4*)(U + off + bj * HALF) = pack8(h0 * av[bj][0], h1 * av[bj][1]); }
                    ss += __shfl_xor(ss, 16); ss += __shfl_xor(ss, 32);
                    if (fq == 0) ((PG8_LAS float*)ldsx)[(rt0 + ai * HALF + m * 16) * 4 + wc] = ss;
                    if (m & 1) asm volatile("" ::: "memory"); }
            asm volatile("s_waitcnt lgkmcnt(0)" ::: "memory"); __builtin_amdgcn_s_barrier(); asm volatile("" ::: "memory");
            { const int lane_ = lane_id(), wid_ = wr * 4 + wc, prow_ = wid_ * 32 + (lane_ & 31);
              if (lane_ < 32) { const f32x4 p4 = *(const PG8_LAS f32x4*)((PG8_LAS float*)ldsx + prow_ * 4); xbuf[(size_t)(u.pm * BM + prow_) * 4 + u.pn] = (p4[0] + p4[1]) + (p4[2] + p4[3]); } }
            asm volatile("s_waitcnt lgkmcnt(0)" ::: "memory"); __builtin_amdgcn_s_barrier(); asm volatile("" ::: "memory");
            return;
        }
        const int lane = lane_id(), wid = wr * 4 + wc;
        PG8_LAS float* P = (PG8_LAS float*)ldsx; PG8_LAS float* S = (PG8_LAS float*)(ldsx + 4096);
        {
            f32x4 g[2][2];
#pragma unroll
            for (int bj = 0; bj < 2; ++bj)
#pragma unroll
                for (int n = 0; n < 2; ++n) g[bj][n] = *(const f32x4*)(mb + gslot * DM + bj * HALF + n * 4);
            if (BASE_BF16) {
#pragma unroll
                for (int ai = 0; ai < 2; ++ai) {
                    u32x2 bb[4][2][2];
#pragma unroll
                    for (int m = 0; m < 4; ++m) { const size_t off = (size_t)(row0 + ai * HALF + m * 16) * DM + col0;
#pragma unroll
                        for (int bj = 0; bj < 2; ++bj)
#pragma unroll
                            for (int n = 0; n < 2; ++n) bb[m][bj][n] = *(const u32x2*)((const bf16_t*)base_ + off + bj * HALF + n * 4); }
#pragma unroll
                    for (int m = 0; m < 4; ++m) { float ss = 0.f;
#pragma unroll
                        for (int bj = 0; bj < 2; ++bj)
#pragma unroll
                            for (int n = 0; n < 2; ++n) { const u32x2 w = bb[m][bj][n];
                                const f32x4 b = (f32x4){__uint_as_float(w.x << 16), __uint_as_float(w.x & 0xffff0000u), __uint_as_float(w.y << 16), __uint_as_float(w.y & 0xffff0000u)};
                                const f32x4 h = b + g[bj][n] * acc[ai][bj][m][n]; acc[ai][bj][m][n] = h; ss += sumsq4(h); }
                        ss += __shfl_xor(ss, 16); ss += __shfl_xor(ss, 32);
                        if (fq == 0) P[(rt0 + ai * HALF + m * 16) * 4 + wc] = ss; }
                    asm volatile("" ::: "memory");
                }
            } else {
#pragma unroll
                for (int ai = 0; ai < 2; ++ai)
#pragma unroll
                    for (int m = 0; m < 4; ++m) { const size_t off = (size_t)(row0 + ai * HALF + m * 16) * DM + col0; float ss = 0.f;
#pragma unroll
                        for (int bj = 0; bj < 2; ++bj)
#pragma unroll
                            for (int n = 0; n < 2; ++n) { const f32x4 b = *(const f32x4*)((const float*)base_ + off + bj * HALF + n * 4); const f32x4 h = b + g[bj][n] * acc[ai][bj][m][n]; acc[ai][bj][m][n] = h; ss += sumsq4(h); }
                        ss += __shfl_xor(ss, 16); ss += __shfl_xor(ss, 32);
                        if (fq == 0) P[(rt0 + ai * HALF + m * 16) * 4 + wc] = ss;
                        if (m & 1) asm volatile("" ::: "memory"); }
            }
        }
        asm volatile("s_waitcnt lgkmcnt(0)" ::: "memory"); __builtin_amdgcn_s_barrier(); asm volatile("" ::: "memory");
        const int prow = wid * 32 + (lane & 31);
        float* slot = xbuf + ((size_t)(u.pm * BM + prow) * 4);
        if (lane < 32) { const f32x4 p4 = *(const PG8_LAS f32x4*)(P + prow * 4); __hip_atomic_store(slot + u.pn, (p4[0] + p4[1]) + (p4[2] + p4[3]), __ATOMIC_RELAXED, __HIP_MEMORY_SCOPE_AGENT); }
        asm volatile("s_waitcnt vmcnt(0)" ::: "memory");
        unsigned* cw = cnt + 64 * u.pm;
        if (lane == 0) __hip_atomic_fetch_add(cw, 1u, __ATOMIC_RELAXED, __HIP_MEMORY_SCOPE_AGENT);
        { unsigned sp = 0;
          while ((unsigned)__builtin_amdgcn_readfirstlane(__hip_atomic_load(cw, __ATOMIC_RELAXED, __HIP_MEMORY_SCOPE_AGENT)) < want) { __builtin_amdgcn_s_sleep(1); if (++sp > (1u << 22)) break; } }
        __builtin_amdgcn_fence(__ATOMIC_ACQUIRE, "agent");
        if (lane < 32) {
            const unsigned long long w0 = __hip_atomic_load((const unsigned long long*)slot, __ATOMIC_RELAXED, __HIP_MEMORY_SCOPE_AGENT), w1 = __hip_atomic_load((const unsigned long long*)slot + 1, __ATOMIC_RELAXED, __HIP_MEMORY_SCOPE_AGENT);
            const float s = (__uint_as_float((unsigned)w0) + __uint_as_float((unsigned)(w0 >> 32))) + (__uint_as_float((unsigned)w1) + __uint_as_float((unsigned)(w1 >> 32)));
            S[prow] = __builtin_amdgcn_rsqf(s * (1.f / DM) + NORM_EPS);
        }
        f32x4 av[2][2], sv[2][2];
#pragma unroll
        for (int bj = 0; bj < 2; ++bj)
#pragma unroll
            for (int n = 0; n < 2; ++n) {
                if (FINAL) { av[bj][n] = *(const f32x4*)(fn + col0 + bj * HALF + n * 4); sv[bj][n] = (f32x4){0.f, 0.f, 0.f, 0.f}; }
                else { av[bj][n] = *(const f32x4*)(mb + (sslot + 1) * DM + bj * HALF + n * 4); sv[bj][n] = *(const f32x4*)(mb + sslot * DM + bj * HALF + n * 4); } }
        asm volatile("s_waitcnt lgkmcnt(0)" ::: "memory"); __builtin_amdgcn_s_barrier(); asm volatile("" ::: "memory");
#pragma unroll
        for (int ai = 0; ai < 2; ++ai)
#pragma unroll
            for (int m = 0; m < 4; ++m) {
                const size_t off = (size_t)(row0 + ai * HALF + m * 16) * DM + col0; const float r = S[rt0 + ai * HALF + m * 16];
#pragma unroll
                for (int bj = 0; bj < 2; ++bj)
#pragma unroll
                    for (int n = 0; n < 2; ++n) { const f32x4 h = acc[ai][bj][m][n];
                        if (FINAL) { *(f32x4*)((float*)out_ + off + bj * HALF + n * 4) = h * r * av[bj][n]; }
                        else { if (OUT_BF16) *(u32x2*)((bf16_t*)out_ + off + bj * HALF + n * 4) = pack4(h); else *(f32x4*)((float*)out_ + off + bj * HALF + n * 4) = h;
                               *(u32x2*)(U + off + bj * HALF + n * 4) = pack4(h * r * av[bj][n] + sv[bj][n]); } }
            }
        asm volatile("s_waitcnt lgkmcnt(0)" ::: "memory"); __builtin_amdgcn_s_barrier(); asm volatile("" ::: "memory");
    }
};
struct EpiProj {
    static constexpr bool PERM = true, AFTER_DRAIN = false, MIDK = false;
    unsigned char* ws;
    __device__ __forceinline__ void operator()(f32x4 (&acc)[2][2][4][2], const Unit& u, int wr, int wc, int fr, int fq) const {
        asm volatile("" : "+v"(fr), "+v"(fq));
        deferred_norm_fixup(acc, u, wr, wc, fr, fq, (const float*)(ws + WS_XBUF), (const float*)(ws + WS_CV1), 2304);
        const int pn = u.pn, row0 = u.pm * BM + wr * 64 + fr;
        bf16_t* const DQ = (bf16_t*)(ws + WS_DQ); bf16_t* const DK = (bf16_t*)(ws + WS_DK); bf16_t* const DV = (bf16_t*)(ws + WS_DV); bf16_t* const CQ = (bf16_t*)(ws + WS_CQ); bf16_t* const CKV = (bf16_t*)(ws + WS_CKV); bf16_t* const KR = (bf16_t*)(ws + WS_KR);
        float* const SSCQ = (float*)(ws + WS_SSCQ); float* const SSCKV = (float*)(ws + WS_SSCKV);
        const float* const COSD = (const float*)(ws + WS_COSD); const float* const SIND = (const float*)(ws + WS_SIND); const float* const COSR = (const float*)(ws + WS_COSR); const float* const SINR = (const float*)(ws + WS_SINR);
        if (pn < 4) {
            bf16_t* dst = (pn < 2) ? DQ : DK; const float sc = (pn < 2) ? QSC_DIFF : 1.f; const int colb = 256 * (pn & 1) + 64 * wc + 8 * fq;
#pragma unroll
            for (int ai = 0; ai < 2; ++ai)
#pragma unroll
                for (int m = 0; m < 4; ++m) {
                    const int row = row0 + ai * HALF + m * 16;
                    const f32x4 c0 = *(const f32x4*)(COSD + (size_t)row * 32 + 8 * fq), c1 = *(const f32x4*)(COSD + (size_t)row * 32 + 8 * fq + 4);
                    const f32x4 s0 = *(const f32x4*)(SIND + (size_t)row * 32 + 8 * fq), s1 = *(const f32x4*)(SIND + (size_t)row * 32 + 8 * fq + 4);
                    const f32x4 x1a = acc[ai][0][m][0], x1b = acc[ai][0][m][1], x2a = acc[ai][1][m][0], x2b = acc[ai][1][m][1];
                    const f32x4 y1a = (x1a * c0 - x2a * s0) * sc, y1b = (x1b * c1 - x2b * s1) * sc, y2a = (x2a * c0 + x1a * s0) * sc, y2b = (x2b * c1 + x1b * s1) * sc;
                    bf16_t* rp = dst + (size_t)row * 512 + colb;
                    *(u32x4*)rp = pack8(y1a, y1b); *(u32x4*)(rp + 32) = pack8(y2a, y2b);
                    asm volatile("" ::: "memory");
                }
        } else if (pn < 6) {
            const int colb = 256 * (pn - 4) + 32 * wc + 8 * fq;
#pragma unroll
            for (int ai = 0; ai < 2; ++ai)
#pragma unroll
                for (int m = 0; m < 4; ++m) { bf16_t* rp = DV + (size_t)(row0 + ai * HALF + m * 16) * 512 + colb;
#pragma unroll
                    for (int bj = 0; bj < 2; ++bj) *(u32x4*)(rp + bj * HALF) = pack8(acc[ai][bj][m][0], acc[ai][bj][m][1]); }
        } else if (pn == 6) {
            const int colb = 32 * wc + 8 * fq;
#pragma unroll
            for (int ai = 0; ai < 2; ++ai)
#pragma unroll
                for (int m = 0; m < 4; ++m) { const int row = row0 + ai * HALF + m * 16; bf16_t* rp = CQ + (size_t)row * 384 + colb; float ss = 0.f;
#pragma unroll
                    for (int bj = 0; bj < 2; ++bj) { *(u32x4*)(rp + bj * HALF) = pack8(acc[ai][bj][m][0], acc[ai][bj][m][1]); ss += sumsq4(acc[ai][bj][m][0]) + sumsq4(acc[ai][bj][m][1]); }
                    ss += __shfl_xor(ss, 16); ss += __shfl_xor(ss, 32); if (fq == 0) SSCQ[(size_t)row * 8 + wc] = ss; }
        } else if (pn == 7) {
#pragma unroll
            for (int ai = 0; ai < 2; ++ai)
#pragma unroll
                for (int m = 0; m < 4; ++m) { const int row = row0 + ai * HALF + m * 16; bf16_t* rp = CQ + (size_t)row * 384 + 256 + 32 * wc + 8 * fq;
                    *(u32x4*)rp = pack8(acc[ai][0][m][0], acc[ai][0][m][1]); float ss = sumsq4(acc[ai][0][m][0]) + sumsq4(acc[ai][0][m][1]);
                    ss += __shfl_xor(ss, 16); ss += __shfl_xor(ss, 32); if (fq == 0) SSCQ[(size_t)row * 8 + 4 + wc] = ss;
                    if (wc == 0) {
                        const f32x4 c = *(const f32x4*)(COSR + (size_t)row * 16 + 4 * fq), s = *(const f32x4*)(SINR + (size_t)row * 16 + 4 * fq);
                        const f32x4 x1 = acc[ai][1][m][0], x2 = acc[ai][1][m][1];
                        bf16_t* kp = KR + (size_t)row * 32 + 4 * fq;
                        *(u32x2*)kp = pack4(x1 * c - x2 * s); *(u32x2*)(kp + 16) = pack4(x2 * c + x1 * s);
                    } }
        } else {
            const int colb = 32 * wc + 8 * fq;
#pragma unroll
            for (int ai = 0; ai < 2; ++ai)
#pragma unroll
                for (int m = 0; m < 4; ++m) { const int row = row0 + ai * HALF + m * 16; bf16_t* rp = CKV + (size_t)row * 256 + colb; float ss = 0.f;
#pragma unroll
                    for (int bj = 0; bj < 2; ++bj) { *(u32x4*)(rp + bj * HALF) = pack8(acc[ai][bj][m][0], acc[ai][bj][m][1]); ss += sumsq4(acc[ai][bj][m][0]) + sumsq4(acc[ai][bj][m][1]); }
                    ss += __shfl_xor(ss, 16); ss += __shfl_xor(ss, 32); if (fq == 0) SSCKV[(size_t)row * 4 + wc] = ss; }
        }
    }
};
struct EpiUq {
    static constexpr bool PERM = true, AFTER_DRAIN = false, MIDK = false;
    unsigned char* ws;
    __device__ __forceinline__ void operator()(const f32x4 (&acc)[2][2][4][2], const Unit& u, int wr, int wc, int fr, int fq) const {
        const int pn = u.pn, row0 = u.pm * BM + wr * 64 + fr;
        bf16_t* const MQ = (bf16_t*)(ws + WS_MQ); const float* const SSCQ = (const float*)(ws + WS_SSCQ); const float* const COSR = (const float*)(ws + WS_COSR); const float* const SINR = (const float*)(ws + WS_SINR);
#pragma unroll
        for (int ai = 0; ai < 2; ++ai)
#pragma unroll
            for (int m = 0; m < 4; ++m) { const int row = row0 + ai * HALF + m * 16;
                const f32x4 sa = *(const f32x4*)(SSCQ + (size_t)row * 8), sb = *(const f32x4*)(SSCQ + (size_t)row * 8 + 4);
                const float ssq = ((sa[0] + sa[1]) + (sa[2] + sa[3])) + ((sb[0] + sb[1]) + (sb[2] + sb[3]));
                const float r = __builtin_amdgcn_rsqf(ssq * (1.f / 384.f) + NORM_EPS) * QSC_MLA;
                bf16_t* hp = MQ + (size_t)row * 384 + (2 * pn + (wc >> 1)) * 96 + 32 * (wc & 1) + 8 * fq;
                *(u32x4*)hp = pack8(acc[ai][0][m][0] * r, acc[ai][0][m][1] * r);
                if (wc < 2) {
                    const f32x4 c = *(const f32x4*)(COSR + (size_t)row * 16 + 4 * fq), s = *(const f32x4*)(SINR + (size_t)row * 16 + 4 * fq);
                    const f32x4 x1 = acc[ai][1][m][0] * r, x2 = acc[ai][1][m][1] * r;
                    bf16_t* rp = MQ + (size_t)row * 384 + (2 * pn + wc) * 96 + 64 + 4 * fq;
                    *(u32x2*)rp = pack4(x1 * c - x2 * s); *(u32x2*)(rp + 16) = pack4(x2 * c + x1 * s);
                }
                asm volatile("" ::: "memory"); }
    }
};
struct EpiUkv {
    static constexpr bool PERM = true, AFTER_DRAIN = false, MIDK = false;
    unsigned char* ws;
    __device__ __forceinline__ void operator()(const f32x4 (&acc)[2][2][4][2], const Unit& u, int wr, int wc, int fr, int fq) const {
        const int pn = u.pn, row0 = u.pm * BM + wr * 64 + fr;
        bf16_t* const MK = (bf16_t*)(ws + WS_MK); bf16_t* const MV = (bf16_t*)(ws + WS_MV); const float* const SSCKV = (const float*)(ws + WS_SSCKV);
#pragma unroll
        for (int ai = 0; ai < 2; ++ai)
#pragma unroll
            for (int m = 0; m < 4; ++m) { const int row = row0 + ai * HALF + m * 16;
                const f32x4 sa = *(const f32x4*)(SSCKV + (size_t)row * 4);
                const float r = __builtin_amdgcn_rsqf(((sa[0] + sa[1]) + (sa[2] + sa[3])) * (1.f / 256.f) + NORM_EPS);
                bf16_t* rp = (pn == 0) ? (MK + (size_t)row * 256 + 32 * wc + 8 * fq) : (MV + (size_t)row * 512 + 256 * (pn - 1) + 32 * wc + 8 * fq);
#pragma unroll
                for (int bj = 0; bj < 2; ++bj) *(u32x4*)(rp + bj * HALF) = pack8(acc[ai][bj][m][0] * r, acc[ai][bj][m][1] * r);
                asm volatile("" ::: "memory"); }
    }
};
}

#define LAS __attribute__((address_space(3)))
namespace att {
typedef unsigned short bf16_t;
typedef short bf16x8 __attribute__((ext_vector_type(8)));
typedef short s16x4 __attribute__((ext_vector_type(4)));
typedef float f32x16 __attribute__((ext_vector_type(16)));
typedef float f32x4 __attribute__((ext_vector_type(4)));
typedef unsigned u32x4 __attribute__((ext_vector_type(4)));
typedef unsigned u32x2 __attribute__((ext_vector_type(2)));
constexpr int KBUF = 13312, VBUF = 16384, KOFF = 0, VOFF = 2 * KBUF, ATT_LDS = VOFF + 2 * VBUF;
__device__ __forceinline__ int crow(int r, int hi) { return (r & 3) + 8 * (r >> 2) + 4 * hi; }
__device__ __forceinline__ unsigned cvtpk(float lo, float hi) { unsigned r; asm volatile("v_cvt_pk_bf16_f32 %0, %1, %2" : "=v"(r) : "v"(lo), "v"(hi)); return r; }
__device__ __forceinline__ s16x4 vtr(const LAS unsigned char* p) { return __builtin_bit_cast(s16x4, __builtin_amdgcn_ds_read_tr16_b64_v4i16((LAS s16x4*)p)); }

__device__ __forceinline__ void glds16(const void* gsrc, unsigned lds_dst) { unsigned keep;
    asm volatile("s_mov_b32 %0, m0\n\ts_mov_b32 m0, %2\n\ts_nop 0\n\tglobal_load_lds_dwordx4 %1, off\n\ts_mov_b32 m0, %0" : "=&s"(keep) : "v"(gsrc), "s"(lds_dst) : "memory"); }
struct PassArgs { const bf16_t* Q; int pq; const bf16_t* K1; int pk1; const bf16_t* K2; int pk2; const bf16_t* V; int pv; };

template <int DQK>
__device__ __forceinline__ void flash_pass(f32x16 (&o)[4], float& l_out, const PassArgs& a, int q0, LAS unsigned char* lds, int tid, int wid, int lane) {
    const int r32 = lane & 31, hi = lane >> 5;
    bf16x8 qr[DQK / 16];
    { const bf16_t* qp = a.Q + (size_t)(q0 + wid * 32 + r32) * a.pq + hi * 8;
#pragma unroll
      for (int d0 = 0; d0 < DQK / 16; ++d0) qr[d0] = *(const bf16x8*)(qp + d0 * 16); }
    const unsigned kgo0 = (unsigned)(lane * a.pk1 + wid * 8) * 2u, kgo1 = (unsigned)(lane * a.pk2 + (wid & 3) * 8) * 2u;
    const size_t kstep0 = (size_t)(64 * a.pk1) * 2, kstep1 = (size_t)(64 * a.pk2) * 2, vstep = (size_t)(64 * a.pv) * 2;
    unsigned vgo[2];
#pragma unroll
    for (int i = 0; i < 2; ++i) { const int p = wid + 8 * i; vgo[i] = (unsigned)((16 * (p & 3) + (lane >> 2)) * a.pv + (4 * (p >> 2) + (lane & 3)) * 8) * 2u; }
    const int NT = (q0 + 256) >> 6;
    const int wq_lo = q0 + wid * 32, qrow = wq_lo + r32;
    float m_ref = -1e30f, l_run = 0.f;
#pragma unroll
    for (int db = 0; db < 4; ++db)
#pragma unroll
        for (int r = 0; r < 16; ++r) o[db][r] = 0.f;
    const unsigned kfo = (unsigned)(hi * 1024 + r32 * 16);
    const unsigned vfo = (unsigned)((4 * hi + ((lane & 15) >> 2)) * 64 + ((lane >> 4) & 1) * 32 + (lane & 3) * 8);
#define ATT_GLDS(g, l) glds16((const void*)(g), (unsigned)__builtin_amdgcn_readfirstlane((int)(unsigned)(uintptr_t)(l)))
#define ATT_DMAK(t, b) do { ATT_GLDS((const char*)a.K1 + (size_t)(t) * kstep0 + kgo0, lds + KOFF + (b) * KBUF + wid * 1024); \
        if (DQK == 96 && wid < 4) ATT_GLDS((const char*)a.K2 + (size_t)(t) * kstep1 + kgo1, lds + KOFF + (b) * KBUF + (8 + wid) * 1024); } while (0)
#define ATT_DMAV(t, b) do { _Pragma("unroll") for (int i = 0; i < 2; ++i) ATT_GLDS((const char*)a.V + (size_t)(t) * vstep + vgo[i], lds + VOFF + (b) * VBUF + (wid + 8 * i) * 1024); } while (0)
#define ATT_SYNC() do { asm volatile("s_waitcnt vmcnt(0)" ::: "memory"); __syncthreads(); } while (0)
#define ATT_SB() __builtin_amdgcn_sched_barrier(0)
#define ATT_KRD(dst, kb_, d0) do { dst[0] = *(const LAS bf16x8*)(kb_ + (d0) * 2048); dst[1] = *(const LAS bf16x8*)(kb_ + (d0) * 2048 + 512); } while (0)
#define ATT_KMM(P0, P1, src, d0) do { \
        if ((d0) == 0) { P0 = __builtin_amdgcn_mfma_f32_32x32x16_bf16(src[0], qr[d0], zero16, 0, 0, 0); P1 = __builtin_amdgcn_mfma_f32_32x32x16_bf16(src[1], qr[d0], zero16, 0, 0, 0); } \
        else { P0 = __builtin_amdgcn_mfma_f32_32x32x16_bf16(src[0], qr[d0], P0, 0, 0, 0); P1 = __builtin_amdgcn_mfma_f32_32x32x16_bf16(src[1], qr[d0], P1, 0, 0, 0); } } while (0)
#define ATT_QK(P0, P1, b) do { const LAS unsigned char* kb_ = lds + KOFF + (b) * KBUF + kfo; bf16x8 ka_[2], kc_[2]; \
        ATT_KRD(ka_, kb_, 0); ATT_SB(); ATT_KRD(kc_, kb_, 1); ATT_SB(); ATT_KMM(P0, P1, ka_, 0); ATT_SB(); \
        ATT_KRD(ka_, kb_, 2); ATT_SB(); ATT_KMM(P0, P1, kc_, 1); ATT_SB(); \
        ATT_KRD(kc_, kb_, 3); ATT_SB(); ATT_KMM(P0, P1, ka_, 2); ATT_SB(); \
        if (DQK == 96) { ATT_KRD(ka_, kb_, 4); ATT_SB(); } \
        ATT_KMM(P0, P1, kc_, 3); ATT_SB(); \
        if (DQK == 96) { ATT_KRD(kc_, kb_, 5); ATT_SB(); ATT_KMM(P0, P1, ka_, 4); ATT_SB(); ATT_KMM(P0, P1, kc_, 5); ATT_SB(); } } while (0)
#define ATT_VRD(dst, vb_, j) do { _Pragma("unroll") for (int s_ = 0; s_ < 2; ++s_) { dst[2 * s_] = vtr(vb_ + (((j) >> 1) * 4 + 2 * ((j) & 1) + s_) * 1024); dst[2 * s_ + 1] = vtr(vb_ + (((j) >> 1) * 4 + 2 * ((j) & 1) + s_) * 1024 + 512); } } while (0)
#define ATT_VMM(PW, src, j) do { _Pragma("unroll") for (int s_ = 0; s_ < 2; ++s_) { \
        const bf16x8 vf_ = (bf16x8){src[2 * s_][0], src[2 * s_][1], src[2 * s_][2], src[2 * s_][3], src[2 * s_ + 1][0], src[2 * s_ + 1][1], src[2 * s_ + 1][2], src[2 * s_ + 1][3]}; \
        o[(j) >> 1] = __builtin_amdgcn_mfma_f32_32x32x16_bf16(vf_, __builtin_bit_cast(bf16x8, PW[2 * ((j) & 1) + s_]), o[(j) >> 1], 0, 0, 0); } } while (0)
#define ATT_PV(PW, b) do { const LAS unsigned char* vb_ = lds + VOFF + (b) * VBUF + vfo; s16x4 va_[4], vc_[4]; \
        ATT_VRD(va_, vb_, 0); ATT_SB(); \
        ATT_VRD(vc_, vb_, 1); ATT_SB(); ATT_VMM(PW, va_, 0); ATT_SB(); ATT_VRD(va_, vb_, 2); ATT_SB(); ATT_VMM(PW, vc_, 1); ATT_SB(); \
        ATT_VRD(vc_, vb_, 3); ATT_SB(); ATT_VMM(PW, va_, 2); ATT_SB(); ATT_VRD(va_, vb_, 4); ATT_SB(); ATT_VMM(PW, vc_, 3); ATT_SB(); \
        ATT_VRD(vc_, vb_, 5); ATT_SB(); ATT_VMM(PW, va_, 4); ATT_SB(); ATT_VRD(va_, vb_, 6); ATT_SB(); ATT_VMM(PW, vc_, 5); ATT_SB(); \
        ATT_VRD(vc_, vb_, 7); ATT_SB(); ATT_VMM(PW, va_, 6); ATT_SB(); ATT_VMM(PW, vc_, 7); ATT_SB(); } while (0)
#define ATT_SOFTMAX(t, P0, P1, PW) do { \
        if (64 * (t) + 63 > wq_lo) { const int kb0_ = 64 * (t) + 4 * hi; \
            _Pragma("unroll") for (int r = 0; r < 16; ++r) { const int kv_ = kb0_ + (r & 3) + 8 * (r >> 2); if (kv_ > qrow) P0[r] = -1e30f; if (kv_ + 32 > qrow) P1[r] = -1e30f; } } \
        float mx_ = fmaxf(P0[0], P1[0]); \
        _Pragma("unroll") for (int r = 1; r < 16; ++r) mx_ = fmaxf(mx_, fmaxf(P0[r], P1[r])); \
        mx_ = fmaxf(mx_, __shfl_xor(mx_, 32)); \
        if (__any(mx_ > m_ref + 8.f)) { const float mn_ = fmaxf(m_ref, mx_), al_ = __builtin_amdgcn_exp2f(m_ref - mn_); m_ref = mn_; l_run *= al_; \
            _Pragma("unroll") for (int db = 0; db < 4; ++db) _Pragma("unroll") for (int r = 0; r < 16; ++r) o[db][r] *= al_; } \
        float rs_ = 0.f; \
        _Pragma("unroll") for (int r = 0; r < 16; ++r) { P0[r] = __builtin_amdgcn_exp2f(P0[r] - m_ref); P1[r] = __builtin_amdgcn_exp2f(P1[r] - m_ref); rs_ += P0[r] + P1[r]; } \
        l_run += rs_; \
        _Pragma("unroll") for (int j = 0; j < 4; ++j) { PW[0][j] = cvtpk(P0[2 * j], P0[2 * j + 1]); PW[1][j] = cvtpk(P0[8 + 2 * j], P0[9 + 2 * j]); PW[2][j] = cvtpk(P1[2 * j], P1[2 * j + 1]); PW[3][j] = cvtpk(P1[8 + 2 * j], P1[9 + 2 * j]); } } while (0)
#define ATT_NEED(t) (64 * (t) <= wq_lo + 31)
#define ATT_MXC(P0, P1, j) do { mxa_ = __builtin_fmaxf(__builtin_fmaxf(mxa_, P0[2 * (j)]), P0[2 * (j) + 1]); mxb_ = __builtin_fmaxf(__builtin_fmaxf(mxb_, P1[2 * (j)]), P1[2 * (j) + 1]); } while (0)
#define ATT_EXC(P0, P1, PW, c) do { _Pragma("unroll") for (int r = 4 * (c); r < 4 * (c) + 4; ++r) { P0[r] = __builtin_amdgcn_exp2f(P0[r] - m_ref); P1[r] = __builtin_amdgcn_exp2f(P1[r] - m_ref); rs_ += P0[r] + P1[r]; } \
        PW[(c) >> 1][2 * ((c) & 1)] = cvtpk(P0[4 * (c)], P0[4 * (c) + 1]); PW[(c) >> 1][2 * ((c) & 1) + 1] = cvtpk(P0[4 * (c) + 2], P0[4 * (c) + 3]); \
        PW[2 + ((c) >> 1)][2 * ((c) & 1)] = cvtpk(P1[4 * (c)], P1[4 * (c) + 1]); PW[2 + ((c) >> 1)][2 * ((c) & 1) + 1] = cvtpk(P1[4 * (c) + 2], P1[4 * (c) + 3]); } while (0)
#define ATT_FAST(SE0, SE1, SO0, SO1, PAR) do { \
        { const LAS unsigned char* vb_ = lds + VOFF + (1 - (PAR)) * VBUF + vfo; s16x4 va_[4], vc_[4]; float mxa_ = -3.0e38f, mxb_ = -3.0e38f; \
          ATT_VRD(va_, vb_, 0); ATT_SB(); \
          ATT_VRD(vc_, vb_, 1); ATT_SB(); ATT_VMM(pwa, va_, 0); ATT_MXC(SE0, SE1, 0); ATT_SB(); ATT_VRD(va_, vb_, 2); ATT_SB(); ATT_VMM(pwa, vc_, 1); ATT_MXC(SE0, SE1, 1); ATT_SB(); \
          ATT_VRD(vc_, vb_, 3); ATT_SB(); ATT_VMM(pwa, va_, 2); ATT_MXC(SE0, SE1, 2); ATT_SB(); ATT_VRD(va_, vb_, 4); ATT_SB(); ATT_VMM(pwa, vc_, 3); ATT_MXC(SE0, SE1, 3); ATT_SB(); \
          ATT_VRD(vc_, vb_, 5); ATT_SB(); ATT_VMM(pwa, va_, 4); ATT_MXC(SE0, SE1, 4); ATT_SB(); ATT_VRD(va_, vb_, 6); ATT_SB(); ATT_VMM(pwa, vc_, 5); ATT_MXC(SE0, SE1, 5); ATT_SB(); \
          ATT_VRD(vc_, vb_, 7); ATT_SB(); ATT_VMM(pwa, va_, 6); ATT_MXC(SE0, SE1, 6); ATT_SB(); ATT_VMM(pwa, vc_, 7); ATT_MXC(SE0, SE1, 7); ATT_SB(); \
          float mx_ = __builtin_fmaxf(mxa_, mxb_); \
          { auto rr_ = __builtin_amdgcn_permlane32_swap(__float_as_uint(mx_), __float_as_uint(mx_), false, false); mx_ = __builtin_fmaxf(__uint_as_float(rr_[0]), __uint_as_float(rr_[1])); } \
          if (__any(mx_ > m_ref + 8.f)) { const float mn_ = fmaxf(m_ref, mx_), al_ = __builtin_amdgcn_exp2f(m_ref - mn_); m_ref = mn_; l_run *= al_; \
              _Pragma("unroll") for (int db = 0; db < 4; ++db) _Pragma("unroll") for (int r = 0; r < 16; ++r) o[db][r] *= al_; } } \
        { const LAS unsigned char* kb_ = lds + KOFF + (1 - (PAR)) * KBUF + kfo; bf16x8 ka_[2], kc_[2]; float rs_ = 0.f; \
          ATT_KRD(ka_, kb_, 0); ATT_SB(); ATT_KRD(kc_, kb_, 1); ATT_SB(); ATT_KMM(SO0, SO1, ka_, 0); ATT_EXC(SE0, SE1, pwa, 0); ATT_SB(); \
          ATT_KRD(ka_, kb_, 2); ATT_SB(); ATT_KMM(SO0, SO1, kc_, 1); ATT_EXC(SE0, SE1, pwa, 1); ATT_SB(); \
          ATT_KRD(kc_, kb_, 3); ATT_SB(); ATT_KMM(SO0, SO1, ka_, 2); ATT_EXC(SE0, SE1, pwa, 2); ATT_SB(); \
          if (DQK == 96) { ATT_KRD(ka_, kb_, 4); ATT_SB(); } \
          ATT_KMM(SO0, SO1, kc_, 3); ATT_EXC(SE0, SE1, pwa, 3); ATT_SB(); \
          if (DQK == 96) { ATT_KRD(kc_, kb_, 5); ATT_SB(); ATT_KMM(SO0, SO1, ka_, 4); ATT_SB(); ATT_KMM(SO0, SO1, kc_, 5); ATT_SB(); } \
          l_run += rs_; } } while (0)
#define ATT_IVAL(GRP, t, PAR, SE0, SE1, SO0, SO1) do { \
        if ((t) < NT) { if ((t) + 2 < NT) ATT_DMAK((t) + 2, PAR); ATT_DMAV(t, PAR); } \
        if (GRP == 0) { \
            if ((t) + 1 < NT && ATT_NEED((t) + 1)) ATT_QK(SO0, SO1, 1 - (PAR)); \
            if ((t) >= 1 && ATT_NEED((t) - 1)) ATT_PV(pwa, 1 - (PAR)); \
            if ((t) < NT && ATT_NEED(t)) ATT_SOFTMAX(t, SE0, SE1, pwa); \
        } else { \
            if ((t) >= 1 && ATT_NEED((t) - 1)) { ATT_SOFTMAX((t) - 1, SO0, SO1, pwa); ATT_PV(pwa, 1 - (PAR)); } \
            if ((t) + 1 < NT && ATT_NEED((t) + 1)) ATT_QK(SO0, SO1, 1 - (PAR)); \
        } \
        ATT_SYNC(); } while (0)
    f32x16 sa0, sa1, sb0, sb1; u32x4 pwa[4]; f32x16 zero16;
#pragma unroll
    for (int r = 0; r < 16; ++r) zero16[r] = 0.f;
#pragma unroll
    for (int j = 0; j < 4; ++j) pwa[j] = (u32x4){0u, 0u, 0u, 0u};
#ifdef T_GRP
    const int grp = T_GRP;
#else
    const int grp = wid >> 2;
#endif
    ATT_DMAK(0, 0); ATT_DMAK(1, 1); ATT_SYNC();
    ATT_QK(sa0, sa1, 0);
    __syncthreads();
    (void)grp;
#define ATT_FIVAL(t, PAR, SE0, SE1, SO0, SO1) do { if ((t) + 2 < NT) ATT_DMAK((t) + 2, PAR); ATT_DMAV(t, PAR); ATT_FAST(SE0, SE1, SO0, SO1, PAR); ATT_SYNC(); } while (0)
    const int tfmax = (wq_lo >= 127) ? ((wq_lo - 63) >> 6) - 1 : 0;
    ATT_IVAL(0, 0, 0, sa0, sa1, sb0, sb1);
    int t = 1;
    for (; t + 1 <= tfmax; t += 2) {
        ATT_FIVAL(t, 1, sb0, sb1, sa0, sa1);
        ATT_FIVAL(t + 1, 0, sa0, sa1, sb0, sb1);
    }
    for (; t < NT; t += 2) {
        ATT_IVAL(0, t, 1, sb0, sb1, sa0, sa1);
        ATT_IVAL(0, t + 1, 0, sa0, sa1, sb0, sb1);
    }
#undef ATT_FIVAL
#undef ATT_GLDS
#undef ATT_DMAK
#undef ATT_DMAV
#undef ATT_SYNC
#undef ATT_QK
#undef ATT_SB
#undef ATT_KRD
#undef ATT_KMM
#undef ATT_VRD
#undef ATT_VMM
#undef ATT_PV
#undef ATT_SOFTMAX
#undef ATT_NEED
#undef ATT_IVAL
#undef ATT_FAST
#undef ATT_MXC
#undef ATT_EXC
    l_out = l_run + __shfl_xor(l_run, 32);
}
}

constexpr int LDS_BYTES = 147456, MISC_OFF = 131072 + 8192;
typedef unsigned short bf16_t;
typedef float f32x4 __attribute__((ext_vector_type(4)));
typedef unsigned u32x4 __attribute__((ext_vector_type(4)));
typedef unsigned u32x2 __attribute__((ext_vector_type(2)));

struct Args { const void* in[27]; float* out; unsigned char* ws; unsigned long long use_cg; };

__device__ __forceinline__ float wave_sum(float v) {
#pragma unroll
    for (int o = 1; o < 64; o <<= 1) v += __shfl_xor(v, o);
    return v;
}
__device__ __forceinline__ unsigned f2bf(float f) { unsigned u = __builtin_bit_cast(unsigned, f); return (u + 0x7fffu + ((u >> 16) & 1u)) >> 16; }
__device__ __forceinline__ unsigned pk2(float lo, float hi) { return f2bf(lo) | (f2bf(hi) << 16); }

enum { WK_GU = 0, WK_PLAIN = 1, WK_IN = 2, WK_UQ = 3, WK_UKV = 4, WK_OUT = 5 };
template <int KIND>
__device__ __forceinline__ void transpose_item(const float* W, const float* W2, const float* ks1, const float* ks2, int K, int Nsrc, int Ndst, bf16_t* WT, LAS float* scr, int item, int lane) {
    const int nblk = Ndst / 32, kb = item / nblk, nb = item % nblk, k0 = 64 * kb, n0 = 32 * nb;
    const int np = n0 + (lane & 31);
    const float* src = W; int sc = np; bool valid = true;
    if (KIND == WK_GU) { const int tile = np >> 8, p = np & 255; src = (p >> 7) ? W2 : W; sc = tile * 128 + (p & 127); }
    else if (KIND == WK_IN) { const int tile = np >> 8, p = np & 255, bj = p >> 7, wc = (p & 127) >> 5, j = p & 31;
        if (tile < 4) sc = 256 * tile + 64 * wc + 32 * bj + j;
        else if (tile < 6) sc = 256 * tile + p;
        else if (tile == 6) sc = 1536 + p;
        else if (tile == 7) { if (bj == 0) sc = 1792 + p; else if (wc == 0) sc = 2176 + 16 * ((j >> 2) & 1) + 4 * (j >> 3) + (j & 3); else valid = false; }
        else sc = 1920 + p; }
    else if (KIND == WK_UQ) { const int tile = np >> 8, p = np & 255, bj = p >> 7, wc = (p & 127) >> 5, j = p & 31;
        if (bj == 0) sc = (2 * tile + (wc >> 1)) * 96 + 32 * (wc & 1) + j;
        else if (wc < 2) sc = (2 * tile + wc) * 96 + 64 + 16 * ((j >> 2) & 1) + 4 * (j >> 3) + (j & 3);
        else valid = false; }
    else if (KIND == WK_UKV) { if (np < 256) sc = (np >> 6) * 192 + (np & 63); else { const int q = np - 256; sc = (q >> 7) * 192 + 64 + (q & 127); } }
    float vv[32];
#pragma unroll
    for (int i = 0; i < 32; ++i) { const int k = k0 + 2 * i + (lane >> 5); const int ksrc = (KIND == WK_OUT) ? ((k + 512) & 1023) : k; vv[i] = valid ? src[(size_t)ksrc * Nsrc + sc] : 0.f; }
#pragma unroll
    for (int i = 0; i < 32; ++i) { const int kk = 2 * i + (lane >> 5), k = k0 + kk; float v = vv[i];
        if (KIND == WK_UQ || KIND == WK_UKV) v *= ks1[k];
        if (KIND == WK_OUT) v *= (k < 512) ? ks2[k] : ks1[(k - 512) & 127] * 0.8f;
        scr[kk * 33 + (lane & 31)] = v; }
    asm volatile("s_waitcnt lgkmcnt(0)" ::: "memory");
    const int c = lane & 7;
#pragma unroll
    for (int j = 0; j < 4; ++j) { const int n = (lane >> 3) + 8 * j; const LAS float* s = scr + (8 * c) * 33 + n;
        u32x4 o; o.x = pk2(s[0 * 33], s[1 * 33]); o.y = pk2(s[2 * 33], s[3 * 33]); o.z = pk2(s[4 * 33], s[5 * 33]); o.w = pk2(s[6 * 33], s[7 * 33]);
        *(u32x4*)(WT + (size_t)(n0 + n) * K + k0 + 8 * c) = o; }
    asm volatile("s_waitcnt lgkmcnt(0)" ::: "memory");
}

__device__ __forceinline__ void norm_mod_pass(const float* h, bf16_t* u, const float* modf, int slot_sh, int gw, int NGW, int lane, int nrows) {
    constexpr int R = 4;
    for (int row = gw; row < nrows; row += R * NGW) {
        f32x4 v[R][4]; float ss[R];
#pragma unroll
        for (int q = 0; q < R; ++q) { const int rw = (row + q * NGW < nrows) ? row + q * NGW : row; const f32x4* hr = (const f32x4*)(h + (size_t)rw * DM) + lane;
#pragma unroll
            for (int j = 0; j < 4; ++j) v[q][j] = hr[64 * j]; }
#pragma unroll
        for (int q = 0; q < R; ++q) { float s = 0.f;
#pragma unroll
            for (int j = 0; j < 4; ++j) s += (v[q][j][0] * v[q][j][0] + v[q][j][1] * v[q][j][1]) + (v[q][j][2] * v[q][j][2] + v[q][j][3] * v[q][j][3]);
            ss[q] = __builtin_amdgcn_rsqf(wave_sum(s) * (1.f / DM) + NORM_EPS); }
#pragma unroll
        for (int q = 0; q < R; ++q) { const int rw = row + q * NGW; if (rw >= nrows) break;
            const int b = rw >> 11; const float rstd = ss[q];
            const f32x4* ar = (const f32x4*)(modf + (size_t)b * NMOD + (slot_sh + 1) * DM) + lane;
            const f32x4* sr = (const f32x4*)(modf + (size_t)b * NMOD + slot_sh * DM) + lane;
            unsigned long long* o8 = (unsigned long long*)(u + (size_t)rw * DM) + lane;
#pragma unroll
            for (int j = 0; j < 4; ++j) { const f32x4 a = ar[64 * j], sh = sr[64 * j]; const f32x4 y = v[q][j] * rstd * a + sh;
                o8[64 * j] = (unsigned long long)pk2(y[0], y[1]) | ((unsigned long long)pk2(y[2], y[3]) << 32); } }
    }
}

#define XB_TMO      128
#define XB_XCNT(j)  (256  + 64 * (j))
#define XB_XSUB(j)  (1280 + 64 * (j))
#define XB_XGEN(j)  (2304 + 64 * (j))
#define XB_TOP      3328
#define XB_TOPGEN   3392
#define XCD_BAR_WORDS 3456
#define XB_SPIN_CAP (1u << 18)

__device__ __forceinline__ unsigned xb_ld(unsigned* p)              { return __hip_atomic_load(p, __ATOMIC_RELAXED, __HIP_MEMORY_SCOPE_AGENT); }
__device__ __forceinline__ unsigned xb_add(unsigned* p, unsigned v) { return __hip_atomic_fetch_add(p, v, __ATOMIC_RELAXED, __HIP_MEMORY_SCOPE_AGENT); }
__device__ __forceinline__ unsigned xb_xcc_id() { return (unsigned)__builtin_amdgcn_s_getreg((3 << 11) | 20) & 0xFu; }
#define XB_SPIN(cond, bar) do { unsigned _sp = 0; while (cond) { __builtin_amdgcn_s_sleep(1); \
    if ((++_sp & 255u) == 0u) { if (xb_ld(&(bar)[XB_TMO])) break; if (_sp > XB_SPIN_CAP) { atomicAdd(&(bar)[XB_TMO], 1u); break; } } } } while (0)

struct XcdBarrier {
    unsigned* bar; unsigned x; unsigned G;
    volatile LAS unsigned* st;
};

__device__ __forceinline__ XcdBarrier xcd_barrier_post(unsigned* bar, volatile LAS unsigned* st, const bool leader, const unsigned G) {
    XcdBarrier b; b.bar = bar; b.x = xb_xcc_id(); b.st = st; b.G = G;
    if (leader) (void)xb_add(&bar[XB_XCNT(b.x)], 1u);
    return b;
}
__device__ __forceinline__ void xcd_barrier_complete(unsigned* bar, unsigned x, const unsigned G, unsigned& nloc, unsigned& nx) {
    unsigned sum, cnt, mine, sp = 0u;
    for (;;) {
        sum = 0u; cnt = 0u; mine = 0u;
#pragma unroll
        for (unsigned j = 0; j < 16; ++j) { const unsigned c = xb_ld(&bar[XB_XCNT(j)]); sum += c; cnt += (c > 0u) ? 1u : 0u; mine = (j == x) ? c : mine; }
        if (sum == G) break;
        __builtin_amdgcn_s_sleep(1);
        if ((++sp & 255u) == 0u) { if (xb_ld(&bar[XB_TMO])) break; if (sp > XB_SPIN_CAP) { atomicAdd(&bar[XB_TMO], 1u); break; } }
    }
    nloc = mine > 0u ? mine : 1u; nx = cnt > 0u ? cnt : 1u;
}

__device__ __forceinline__ void xcd_barrier(const XcdBarrier& b, const bool leader) {
    asm volatile("s_waitcnt vmcnt(0)" ::: "memory");
    __syncthreads();
    if (leader) {
        unsigned* bar = b.bar;
        __builtin_amdgcn_s_waitcnt(0);
        unsigned nloc = b.st[0], nx = b.st[1];
        if (nloc == 0u) { xcd_barrier_complete(bar, b.x, b.G, nloc, nx); b.st[0] = nloc; b.st[1] = nx; }
        const unsigned old = xb_add(&bar[XB_XSUB(b.x)], 1u);
        const unsigned gen = old / nloc;
        if (old + 1u == (gen + 1u) * nloc) {
            __builtin_amdgcn_fence(__ATOMIC_RELEASE, "agent");
            asm volatile("s_waitcnt vmcnt(0)" ::: "memory");
            const unsigned og = xb_add(&bar[XB_TOP], 1u);
            const unsigned tg = og / nx;
            if (og + 1u == (tg + 1u) * nx) xb_add(&bar[XB_TOPGEN], 1u);
            else XB_SPIN(xb_ld(&bar[XB_TOPGEN]) == tg, bar);
            __builtin_amdgcn_fence(__ATOMIC_ACQUIRE, "agent");
            xb_add(&bar[XB_XGEN(b.x)], 1u);
            asm volatile("s_waitcnt vmcnt(0)" ::: "memory");
        } else {
            XB_SPIN(xb_ld(&bar[XB_XGEN(b.x)]) == gen, bar);
            __builtin_amdgcn_fence(__ATOMIC_ACQUIRE, "agent");
            asm volatile("s_waitcnt vmcnt(0)" ::: "memory");
        }
    }
    __syncthreads();
}

template <class Epi>
__device__ __forceinline__ void run_gemm(LAS unsigned char* lds, const bf16_t* A, const bf16_t* Bt, int N, int K, const Epi& E, const int tid) {
    pg8::Gemm g{A, Bt, M, N, K}; pg8::StaticOrder S; S.init(M, N, (int)gridDim.x, (int)blockIdx.x);
    pg8::gemm_phase<Epi, pg8::StaticOrder, true, GEMM_SP2>(lds, g, S, E, tid);
}

__global__ void __launch_bounds__(512) hymba_fwd(Args args) {
    extern __shared__ __attribute__((aligned(16))) unsigned char lds_raw[];
    LAS unsigned char* lds = (LAS unsigned char*)lds_raw;
    cg::grid_group grid = cg::this_grid();
    const int wid = __builtin_amdgcn_readfirstlane(threadIdx.x >> 6);
#define TID() ((wid << 6) | lane_id())
    const int G = gridDim.x, gw = blockIdx.x * 8 + wid, NGW = G * 8;
    { const int tid = TID(); volatile LAS unsigned* MISC0 = (volatile LAS unsigned*)(lds + MISC_OFF); if (tid < 32) MISC0[tid] = 0u; }
    unsigned char* ws = args.ws;
    volatile LAS unsigned* MISC = (volatile LAS unsigned*)(lds + MISC_OFF);
    __syncthreads();
    const int NISL = (G == 256) ? 8 : 1, isl = (int)blockIdx.x % NISL, GI = G / NISL, jblk = (int)blockIdx.x / NISL;
    const XcdBarrier xbar = xcd_barrier_post((unsigned*)(ws + WS_CTL) + 2048, MISC + 8, TID() == 0, (unsigned)G);
    const XcdBarrier ibar = xcd_barrier_post((unsigned*)(ws + WS_CTL) + 32768 + 4096 * isl, MISC + 10, TID() == 0, (unsigned)GI);
#define GSYNC_ALL() xcd_barrier(xbar, TID() == 0)
#define GSYNC() xcd_barrier(ibar, TID() == 0)
    const float* x = (const float*)args.in[0];
    float* out = args.out;
    float* modf = (float*)(ws + WS_MODF);
    float* COSD = (float*)(ws + WS_COSD); float* SIND = (float*)(ws + WS_SIND); float* COSR = (float*)(ws + WS_COSR); float* SINR = (float*)(ws + WS_SINR);
    float* SSCQ = (float*)(ws + WS_SSCQ); float* SSCKV = (float*)(ws + WS_SSCKV); float* SSOM = (float*)(ws + WS_SSOM);
    bf16_t* WGU1 = (bf16_t*)(ws + WS_WGU1); bf16_t* WD1 = (bf16_t*)(ws + WS_WD1); bf16_t* WGU2 = (bf16_t*)(ws + WS_WGU2); bf16_t* WD2 = (bf16_t*)(ws + WS_WD2);
    bf16_t* WIN = (bf16_t*)(ws + WS_WIN); bf16_t* WOUT = (bf16_t*)(ws + WS_WOUT); bf16_t* WUQ = (bf16_t*)(ws + WS_WUQ); bf16_t* WUKV = (bf16_t*)(ws + WS_WUKV);
    bf16_t* U = (bf16_t*)(ws + WS_U); bf16_t* HID = (bf16_t*)(ws + WS_HID);
    bf16_t* DQ = (bf16_t*)(ws + WS_DQ); bf16_t* DK = (bf16_t*)(ws + WS_DK); bf16_t* DV = (bf16_t*)(ws + WS_DV); bf16_t* CQ = (bf16_t*)(ws + WS_CQ); bf16_t* CKV = (bf16_t*)(ws + WS_CKV);
    bf16_t* KR = (bf16_t*)(ws + WS_KR); bf16_t* MQ = (bf16_t*)(ws + WS_MQ); bf16_t* MK = (bf16_t*)(ws + WS_MK); bf16_t* MV = (bf16_t*)(ws + WS_MV);
    bf16_t* ATT = U; bf16_t* U3 = (bf16_t*)(ws + WS_U3); bf16_t* HB = (bf16_t*)(ws + WS_HB);

    for (int rep0 = 0; rep0 < REP_P0; ++rep0) {
        const int tid = TID(), lane = tid & 63;
        if (REP_P0 > 1) __syncthreads();
        if (blockIdx.x < 144) {
            const float* c = (const float*)args.in[1]; const float* w_ada = (const float*)args.in[3]; const float* b_ada = (const float*)args.in[4];
            LAS float* cs = (LAS float*)lds; LAS float* red = (LAS float*)(lds + 65536);
            for (int i = tid; i < BATCH * DM; i += 512) { const float v = c[i]; cs[i] = v / (1.f + __expf(-v)); }
            __syncthreads();
            const int col = blockIdx.x * 64 + lane;
            float acc[16];
#pragma unroll
            for (int b = 0; b < 16; ++b) acc[b] = 0.f;
            const float* wp = w_ada + (size_t)(wid * 128) * NMOD + col;
            for (int k0 = 0; k0 < 128; k0 += 16) {
                float w[16];
#pragma unroll
                for (int j = 0; j < 16; ++j) w[j] = wp[(size_t)(k0 + j) * NMOD];
#pragma unroll
                for (int j = 0; j < 16; ++j)
#pragma unroll
                    for (int b = 0; b < 16; ++b) acc[b] += cs[b * DM + wid * 128 + k0 + j] * w[j];
            }
#pragma unroll
            for (int b = 0; b < 16; ++b) red[(wid * 16 + b) * 64 + lane] = acc[b];
            __syncthreads();
            const int slot = (blockIdx.x * 64) >> 10;
            const float* gn = (slot == 1) ? (const float*)args.in[5] : (slot == 4) ? (const float*)args.in[9] : (const float*)args.in[22];
#pragma unroll
            for (int h = 0; h < 2; ++h) { const int b = (tid >> 6) + 8 * h; float s = 0.f;
#pragma unroll
                for (int w = 0; w < 8; ++w) s += red[(w * 16 + b) * 64 + lane];
                s += b_ada[col];
                if (slot == 1 || slot == 4 || slot == 7) s = gn[col & 1023] * (1.f + s);
                if (slot == 2 || slot == 8) s *= 0.5f;
                modf[(size_t)b * NMOD + col] = s; }
            __syncthreads();
        }
        if (blockIdx.x == 255 && tid == 0) {
            const float* q1 = (const float*)args.in[11]; const float* k1 = (const float*)args.in[12]; const float* q2 = (const float*)args.in[13]; const float* k2 = (const float*)args.in[14];
            float s1 = 0.f, s2 = 0.f;
            for (int i = 0; i < 64; ++i) { s1 += q1[i] * k1[i]; s2 += q2[i] * k2[i]; }
            *(float*)(ws + WS_LAM) = __expf(s1) - __expf(s2) + 0.2f;
        }
        { const int* pos = (const int*)args.in[2];
          const int gt = blockIdx.x * 512 + tid, NGT = G * 512;
          for (int i = gt; i < M * 32; i += NGT) { const int row = i >> 5, j = i & 31;
              const float inv = exp2f(-(float)(2 * j) * (13.287712379549449f / 64.f)); const float ang = (float)pos[row] * inv;
              const double rv = (double)ang * 0.15915494309189535; const float fr = (float)(rv - __builtin_rint(rv));
              COSD[i] = __builtin_amdgcn_cosf(fr); SIND[i] = __builtin_amdgcn_sinf(fr); }
          for (int i = gt; i < M * 16; i += NGT) { const int row = i >> 4, j = i & 15;
              const float inv = exp2f(-(float)(2 * j) * (13.287712379549449f / 32.f)); const float ang = (float)pos[row] * inv;
              const double rv = (double)ang * 0.15915494309189535; const float fr = (float)(rv - __builtin_rint(rv));
              COSR[i] = __builtin_amdgcn_cosf(fr); SINR[i] = __builtin_amdgcn_sinf(fr); } }
        { LAS float* scr = (LAS float*)(lds + wid * 16384);
          constexpr int I_GU = 16 * 176, I_D = 44 * 32, I_IN = 16 * 72, I_OUT = 16 * 32, I_UQ = 6 * 16, I_UKV = 4 * 24;
          constexpr int NITEMS = 2 * (I_GU + I_D) + I_IN + I_OUT + I_UQ + I_UKV;
          const int gwr = ((blockIdx.x + 112) & 255) * 8 + wid;
          for (int it = gwr; it < NITEMS; it += NGW) {
              int r = it;
              if (r < I_GU) { transpose_item<WK_GU>((const float*)args.in[6], (const float*)args.in[7], nullptr, nullptr, DM, DFF, 2 * DFF, WGU1, scr, r, lane); continue; } r -= I_GU;
              if (r < I_GU) { transpose_item<WK_GU>((const float*)args.in[23], (const float*)args.in[24], nullptr, nullptr, DM, DFF, 2 * DFF, WGU2, scr, r, lane); continue; } r -= I_GU;
              if (r < I_D) { transpose_item<WK_PLAIN>((const float*)args.in[8], nullptr, nullptr, nullptr, DFF, DM, DM, WD1, scr, r, lane); continue; } r -= I_D;
              if (r < I_D) { transpose_item<WK_PLAIN>((const float*)args.in[25], nullptr, nullptr, nullptr, DFF, DM, DM, WD2, scr, r, lane); continue; } r -= I_D;
              if (r < I_IN) { transpose_item<WK_IN>((const float*)args.in[10], nullptr, nullptr, nullptr, DM, 2208, 2304, WIN, scr, r, lane); continue; } r -= I_IN;
              if (r < I_OUT) { transpose_item<WK_OUT>((const float*)args.in[21], nullptr, (const float*)args.in[15], (const float*)args.in[20], DM, DM, DM, WOUT, scr, r, lane); continue; } r -= I_OUT;
              if (r < I_UQ) { transpose_item<WK_UQ>((const float*)args.in[17], nullptr, (const float*)args.in[16], nullptr, 384, 384, 512, WUQ, scr, r, lane); continue; } r -= I_UQ;
              transpose_item<WK_UKV>((const float*)args.in[19], nullptr, (const float*)args.in[18], nullptr, 256, 768, 768, WUKV, scr, r, lane);
          } }
    }
    if (args.use_cg) grid.sync(); else GSYNC_ALL();
    { const int rows_i = M / NISL; norm_mod_pass(x + (size_t)isl * rows_i * DM, U + (size_t)isl * rows_i * DM, modf + (size_t)(isl * (BATCH / NISL)) * NMOD, 0, jblk * 8 + wid, GI * 8, lane_id(), rows_i); }
    {
        const int lane = lane_id();
        float* CV1 = (float*)(ws + WS_CV1); float* CV2 = (float*)(ws + WS_CV2);
        const int nstep = GI * 8;
        for (int n0 = jblk * 8 + wid; n0 < 2304 + 2 * DFF; n0 += 4 * nstep) {
            u32x4 w0[4], w1[4];
#pragma unroll
            for (int q = 0; q < 4; ++q) { const int n = n0 + q * nstep, nn = (n < 2304 + 2 * DFF) ? n : n0; const bf16_t* wrow = (nn < 2304) ? (WIN + (size_t)nn * DM) : (WGU2 + (size_t)(nn - 2304) * DM);
                w0[q] = *(const u32x4*)(wrow + lane * 16); w1[q] = *(const u32x4*)(wrow + lane * 16 + 8); }
#pragma unroll
            for (int q = 0; q < 4; ++q) { const int n = n0 + q * nstep; if (n >= 2304 + 2 * DFF) break;
                const bool first = n < 2304; const int slot = first ? 3 : 6;
                float wf[16];
#pragma unroll
                for (int j = 0; j < 4; ++j) { wf[2 * j] = __uint_as_float(w0[q][j] << 16); wf[2 * j + 1] = __uint_as_float(w0[q][j] & 0xffff0000u); wf[8 + 2 * j] = __uint_as_float(w1[q][j] << 16); wf[9 + 2 * j] = __uint_as_float(w1[q][j] & 0xffff0000u); }
                for (int b = isl * (BATCH / NISL); b < (isl + 1) * (BATCH / NISL); ++b) {
                    const f32x4* sp = (const f32x4*)(modf + (size_t)b * NMOD + slot * DM + lane * 16);
                    float p = 0.f;
#pragma unroll
                    for (int j = 0; j < 4; ++j) { const f32x4 a = sp[j]; p += (a[0] * wf[4 * j] + a[1] * wf[4 * j + 1]) + (a[2] * wf[4 * j + 2] + a[3] * wf[4 * j + 3]); }
                    p = wave_sum(p);
                    if (lane == 0) { if (first) CV1[(size_t)b * 2304 + n] = p; else CV2[(size_t)b * (2 * DFF) + (n - 2304)] = p; }
                }
            }
        }
    }
    GSYNC();
    for (int rep = 0; rep < EXTRA_SYNC; ++rep) grid.sync();
#ifndef NO_SWI1
    for (int rep = 0; rep < REP_P2; ++rep) { pg8::EpiSwiGLU<false> E{HID, DFF, nullptr, nullptr}; run_gemm(lds, U, WGU1, 2 * DFF, DM, E, TID()); }
#endif
    GSYNC();
#ifndef NO_RES1
    for (int rep = 0; rep < REP_P3; ++rep) { pg8::EpiResidNorm<0, 0, 1> E{x, HB, modf, 2, 3, U, nullptr, (float*)(ws + WS_XBUF), (unsigned*)(ws + WS_PCNT), 32u * (unsigned)(rep + 1), lds + 131072, nullptr}; run_gemm(lds, HID, WD1, DM, DFF, E, TID()); }
#endif
    GSYNC();
#ifndef NO_PROJ
    for (int rep = 0; rep < REP_P5; ++rep) { pg8::EpiProj E{ws}; run_gemm(lds, U, WIN, 2304, DM, E, TID()); }
#endif
    GSYNC();
#ifndef NO_UQ
    for (int rep6 = 0; rep6 < REP_P6; ++rep6) { pg8::EpiUq E{ws}; run_gemm(lds, CQ, WUQ, 512, 384, E, TID()); }
#endif
#ifndef NO_UKV
    for (int rep6 = 0; rep6 < REP_P6; ++rep6) { pg8::EpiUkv E{ws}; run_gemm(lds, CKV, WUKV, 768, 256, E, TID()); }
#endif
    GSYNC();
#ifndef NO_ATT
    {
        unsigned* ctr = (unsigned*)(ws + WS_CTL) + 16 + 64 * isl;
        const int upc = 64 / NISL;
        const float lam = *(const float*)(ws + WS_LAM);
        for (;;) {
            int tid_a = TID(); asm volatile("" : "+v"(tid_a));
            const int tid = tid_a, lane = tid & 63;
            const int r32 = lane & 31, hi = lane >> 5;
            unsigned mo_ = MISC_OFF; asm volatile("" : "+s"(mo_));
            volatile LAS unsigned* misc = (volatile LAS unsigned*)(lds + mo_);
            if (tid == 0) misc[0] = atomicAdd(ctr, 1u);
            __syncthreads();
            const unsigned ui = misc[0];
            __syncthreads();
            if (ui >= (unsigned)(16 * upc) * REP_ATT) break;
            const unsigned long long order = 0x7654FE3D2CB1A908ull;
            const int uu = (int)(ui % (unsigned)(16 * upc)), cls = uu / upc, rem = uu % upc, code = (int)((order >> (4 * (15 - cls))) & 15ull);
            const int mla = code >> 3, qb = code & 7, b = isl * (BATCH / NISL) + (rem >> 2), h = rem & 3;
            const int q0 = qb * 256; const size_t rb = (size_t)b * SEQ;
            att::f32x16 o[4]; float l;
            const int myrow = q0 + wid * 32 + r32;
            bf16_t* orow = ATT + (rb + myrow) * DM + (mla ? 0 : 512) + h * 128 + 4 * hi;
#ifdef T_NOMLA
            if (false) {
#elif defined(T_NODIFF)
            if (true) {
#else
            if (mla) {
#endif
                att::PassArgs pa{MQ + rb * 384 + h * 96, 384, MK + rb * 256 + h * 64, 256, KR + rb * 32, 32, MV + rb * 512 + h * 128, 512};
                att::flash_pass<96>(o, l, pa, q0, lds, tid, wid, lane);
                const float il = 1.f / l; float ss = 0.f;
#pragma unroll
                for (int db = 0; db < 4; ++db)
#pragma unroll
                    for (int r = 0; r < 16; ++r) { o[db][r] *= il; ss += o[db][r] * o[db][r]; }
                ss += __shfl_xor(ss, 32);
                if (hi == 0) SSOM[(rb + myrow) * 4 + h] = ss;
#pragma unroll
                for (int db = 0; db < 4; ++db)
#pragma unroll
                    for (int g = 0; g < 4; ++g) { u32x2 w; w.x = att::cvtpk(o[db][4 * g], o[db][4 * g + 1]); w.y = att::cvtpk(o[db][4 * g + 2], o[db][4 * g + 3]); *(u32x2*)(orow + 32 * db + 8 * g) = w; }
            } else {
                LAS unsigned* oast = (LAS unsigned*)(lds + 61440) + wid * 2048 + lane;
                for (int mp = 0; mp < 2; ++mp) {
                    att::PassArgs pa{DQ + rb * 512 + (2 * h + mp) * 64, 512, DK + rb * 512 + (2 * h + mp) * 64, 512, nullptr, 0, DV + rb * 512 + h * 128, 512};
                    att::flash_pass<64>(o, l, pa, q0, lds, tid, wid, lane);
                    const float il = 1.f / l;
                    if (mp == 0) {
#pragma unroll
                        for (int db = 0; db < 4; ++db)
#pragma unroll
                            for (int j = 0; j < 8; ++j) oast[(db * 8 + j) * 64] = att::cvtpk(o[db][2 * j] * il, o[db][2 * j + 1] * il);
                    } else {
                        float ss = 0.f; const float c2 = lam * il;
#pragma unroll
                        for (int db = 0; db < 4; ++db)
#pragma unroll
                            for (int j = 0; j < 8; ++j) { const unsigned w = oast[(db * 8 + j) * 64]; const float a0 = __uint_as_float(w << 16), a1 = __uint_as_float(w & 0xffff0000u);
                                const float d0 = a0 - c2 * o[db][2 * j], d1 = a1 - c2 * o[db][2 * j + 1]; o[db][2 * j] = d0; o[db][2 * j + 1] = d1; ss += d0 * d0 + d1 * d1; }
                        ss += __shfl_xor(ss, 32);
                        const float rstd = __builtin_amdgcn_rsqf(ss * (1.f / 128.f) + NORM_EPS);
#pragma unroll
                        for (int db = 0; db < 4; ++db)
#pragma unroll
                            for (int g = 0; g < 4; ++g) { u32x2 w; w.x = att::cvtpk(o[db][4 * g] * rstd, o[db][4 * g + 1] * rstd); w.y = att::cvtpk(o[db][4 * g + 2] * rstd, o[db][4 * g + 3] * rstd); *(u32x2*)(orow + 32 * db + 8 * g) = w; }
                    }
                }
            }
        }
    }
#endif
    GSYNC();
#ifndef NO_RES2
    { pg8::EpiResidNorm<0, 1, 1, true> E{HB, HB, modf, 5, 6, U3, nullptr, (float*)(ws + WS_XBUF), (unsigned*)(ws + WS_PCNT), 32u * REP_P3 + 32u, lds + 131072, SSOM}; run_gemm(lds, ATT, WOUT, DM, DM, E, TID()); }
#endif
    GSYNC();
#ifndef NO_SWI2
    { pg8::EpiSwiGLU<true> E{HID, DFF, (const float*)(ws + WS_XBUF), (const float*)(ws + WS_CV2)}; run_gemm(lds, U3, WGU2, 2 * DFF, DM, E, TID()); }
#endif
    GSYNC();
#ifndef NO_RES3
    { pg8::EpiResidNorm<1, 1, 0> E{HB, out, modf, 8, 0, nullptr, (const float*)args.in[26], (float*)(ws + WS_XBUF), (unsigned*)(ws + WS_PCNT), 32u, lds + 131072, nullptr}; run_gemm(lds, HID, WD2, DM, DFF, E, TID()); }
#endif
}

extern "C" void kernel_launch(void* const* d_in, const int* in_sizes, int n_in, void* d_out, int out_size, void* d_ws, size_t ws_size, hipStream_t stream) {
    static int grid_blocks = 0;
    if (grid_blocks == 0) {
        if (n_in != 27 || out_size != M * DM || ws_size < WS_END) { fprintf(stderr, "kernel_launch: unexpected shapes (n_in %d, out %d, ws %zu)\n", n_in, out_size, ws_size); grid_blocks = -1; return; }
        int dev = 0, cus = 0, per_cu = 0;
        hipGetDevice(&dev);
        hipDeviceGetAttribute(&cus, hipDeviceAttributeMultiprocessorCount, dev);
        if (hipFuncSetAttribute((const void*)hymba_fwd, hipFuncAttributeMaxDynamicSharedMemorySize, LDS_BYTES) != hipSuccess) { fprintf(stderr, "kernel_launch: hipFuncSetAttribute failed\n"); grid_blocks = -1; return; }
        if (hipOccupancyMaxActiveBlocksPerMultiprocessor(&per_cu, (const void*)hymba_fwd, 512, LDS_BYTES) != hipSuccess || per_cu < 1) { fprintf(stderr, "kernel_launch: occupancy query failed (%d)\n", per_cu); (void)hipGetLastError(); per_cu = 1; }
        grid_blocks = cus * per_cu;
    }
    if (grid_blocks < 0) return;
    (void)hipMemsetAsync((char*)d_ws + WS_CTL, 0, 262144, stream);
    Args a{};
    for (int i = 0; i < 27; ++i) a.in[i] = d_in[i];
    a.out = (float*)d_out; a.ws = (unsigned char*)d_ws; a.use_cg = 0ull;
    void* kargs[] = {&a};
    hipError_t e = hipLaunchCooperativeKernel((const void*)hymba_fwd, dim3(grid_blocks), dim3(512), kargs, LDS_BYTES, stream);
    if (e != hipSuccess) fprintf(stderr, "cooperative launch failed: %s (grid %d)\n", hipGetErrorString(e), grid_blocks);
}
```

```cpp
#include <hip/hip_runtime.h>
#include <hip/hip_cooperative_groups.h>
#include <cstdio>
#include <cstdint>
namespace cg = cooperative_groups;
namespace pg8 {
#define PG8_LAS __attribute__((address_space(3)))
typedef unsigned short bf16_t;
typedef short bf16x8 __attribute__((ext_vector_type(8)));
typedef float f32x4 __attribute__((ext_vector_type(4)));
typedef unsigned u32x4 __attribute__((ext_vector_type(4)));
constexpr int BM = 256, BK = 64, HALF = 128, HTB = HALF * BK * 2  , STAGE_BYTES = 8 * HTB, NXCD = 8, WGM = 8;

__host__ __device__ __forceinline__ int lds_byte(int r, int c) { const int st = (r >> 4) * 2 + (c >> 5), rr = r & 15, cc = c & 31, ob = rr * 64 + cc * 2; return st * 1024 + (ob ^ (((ob >> 9) & 1) << 5)); }
__host__ __device__ __forceinline__ void stage_rc(int b, int& R, int& C) { const int st = b / 1024, sb = b % 1024, swz = sb ^ (((sb >> 9) & 1) << 5); R = (st >> 1) * 16 + swz / 64; C = (st & 1) * 32 + (swz % 64) / 2; }
__host__ __device__ __forceinline__ int perm32(int rho) { const int n = rho >> 4, i = rho & 15; return 8 * (i >> 2) + 4 * n + (i & 3); }

struct Unit { int pm, pn; };
struct Gemm { const bf16_t* A; const bf16_t* Bt; int M, N, K; };

struct StaticOrder {
    int nM, nN, nwg, G, c;
    __host__ __device__ void init(int M, int N, int G_, int c_) { nM = M / BM; nN = N / BM; nwg = nM * nN; G = G_; c = c_; }
    __host__ __device__ bool next(int i, Unit& u) const {
        const long L = (long)i * G + c; if (L >= nwg) return false;
        int wgid = (int)L; { const int q = nwg / NXCD, r = nwg % NXCD, xcd = wgid % NXCD, off = wgid / NXCD; wgid = (xcd < r ? xcd * (q + 1) : r * (q + 1) + (xcd - r) * q) + off; }
        const int nig = WGM * nN, gid = wgid / nig, fm = gid * WGM, gsz = (nM - fm) < WGM ? (nM - fm) : WGM;
        u.pm = fm + ((wgid % nig) % gsz); u.pn = (wgid % nig) / gsz; return true;
    }
    __device__ __forceinline__ void a_ready(const Unit&) const {}
    __device__ __forceinline__ void done(const Unit&) const {}
};

__device__ __forceinline__ unsigned cvt_pk_bf16(float lo, float hi) { unsigned r; asm volatile("v_cvt_pk_bf16_f32 %0, %1, %2" : "=v"(r) : "v"(lo), "v"(hi)); return r; }
typedef float f32x2 __attribute__((ext_vector_type(2)));
template <class Epi, class Sched, bool ALIGN_EPI = false, bool SP2 = false>
__device__ __forceinline__ void gemm_phase(PG8_LAS unsigned char* lds, const Gemm g, const Sched& S, const Epi& E, const int tid_in) {
    int tid_ = tid_in; asm volatile("" : "+v"(tid_)); const int tid = tid_, wid = __builtin_amdgcn_readfirstlane(tid >> 6), lane = tid & 63, wr = wid >> 2, wc = wid & 3, fr = lane & 15, fq = lane >> 4;
    const int K = g.K, nt = K / BK;
    unsigned voffA[2], voffB[2];
#pragma unroll
    for (int i = 0; i < 2; ++i) { int R, C; stage_rc(tid * 16 + i * 8192, R, C); const int Rb = Epi::PERM ? ((R & ~31) + perm32(R & 31)) : R;
        voffA[i] = (unsigned)(R * K + C) * 2u; voffB[i] = (unsigned)(Rb * K + C) * 2u; }
    const size_t kstep = (size_t)(BK * 2);
    const size_t hstep = (size_t)HALF * K * 2;
    const size_t tstep = 2 * hstep;
    const unsigned ldsw = (unsigned)wid * 1024u;
    const int aoff = lds_byte(wr * 64 + fr, fq * 8), boff = lds_byte(wc * 32 + fr, fq * 8);
#define PG8_SA(b, h) (((b) * 2 + (h)) * HTB)
#define PG8_SB(b, h) ((4 + (b) * 2 + (h)) * HTB)
#define PG8_STAGE(bufoff, gbase, voff) do { _Pragma("unroll") for (int _i = 0; _i < 2; ++_i) \
        __builtin_amdgcn_global_load_lds((const unsigned*)((const char*)(gbase) + (voff)[_i]), (PG8_LAS unsigned*)(lds + (bufoff) + ldsw + _i * 8192), 16, 0, 0); } while (0)
#define PG8_LDA(dst, b, h) do { _Pragma("unroll") for (int m = 0; m < 4; ++m) _Pragma("unroll") for (int k = 0; k < 2; ++k) dst[m][k] = *(const PG8_LAS bf16x8*)(lds + PG8_SA(b, h) + aoff + m * 2048 + k * 1024); } while (0)
#define PG8_LDB(dst, b, h) do { _Pragma("unroll") for (int n = 0; n < 2; ++n) _Pragma("unroll") for (int k = 0; k < 2; ++k) dst[n][k] = *(const PG8_LAS bf16x8*)(lds + PG8_SB(b, h) + boff + n * 2048 + k * 1024); } while (0)
#define PG8_MMA(ai, bj, At, Bt) do { __builtin_amdgcn_s_setprio(1); _Pragma("unroll") for (int m = 0; m < 4; ++m) _Pragma("unroll") for (int n = 0; n < 2; ++n) _Pragma("unroll") for (int k = 0; k < 2; ++k) \
        acc[ai][bj][m][n] = __builtin_amdgcn_mfma_f32_16x16x32_bf16(Bt[n][k], At[m][k], acc[ai][bj][m][n], 0, 0, 0); __builtin_amdgcn_s_setprio(0); } while (0)
#define PG8_WAIT_V(n) asm volatile("s_waitcnt vmcnt(" #n ")" ::: "memory")
#define PG8_WAIT_L(n) asm volatile("s_waitcnt lgkmcnt(" #n ")" ::: "memory")
#define PG8_BAR __builtin_amdgcn_s_barrier()
#define PG8_SCHED __builtin_amdgcn_sched_barrier(0)
    Unit cur, nxt; int ui = 0;
    if (!S.next(0, cur)) return;
    f32x4 acc[2][2][4][2];
#pragma unroll
    for (int a = 0; a < 2; ++a)
#pragma unroll
        for (int b = 0; b < 2; ++b)
#pragma unroll
            for (int m = 0; m < 4; ++m)
#pragma unroll
                for (int n = 0; n < 2; ++n) acc[a][b][m][n] = (f32x4){0.f, 0.f, 0.f, 0.f};
    bf16x8 At[4][2], B0[2][2], B1[2][2];
    const char* cA = (const char*)g.A + (size_t)cur.pm * tstep; const char* cB = (const char*)g.Bt + (size_t)cur.pn * tstep;
    S.a_ready(cur);
    if constexpr (SP2) {
        PG8_STAGE(PG8_SB(0, 0), cB, voffB); PG8_STAGE(PG8_SB(0, 1), cB + hstep, voffB); PG8_STAGE(PG8_SA(0, 0), cA, voffA); PG8_STAGE(PG8_SA(0, 1), cA + hstep, voffA);
        if (wr == 1) PG8_BAR;
        PG8_WAIT_V(2); PG8_BAR;
        PG8_STAGE(PG8_SB(1, 0), cB + kstep, voffB); PG8_STAGE(PG8_SA(1, 0), cA + kstep, voffA); PG8_STAGE(PG8_SB(1, 1), cB + hstep + kstep, voffB);
        PG8_WAIT_V(6); PG8_BAR;
    } else {
        PG8_STAGE(PG8_SB(0, 0), cB, voffB); PG8_STAGE(PG8_SA(0, 0), cA, voffA); PG8_STAGE(PG8_SB(0, 1), cB + hstep, voffB); PG8_STAGE(PG8_SA(0, 1), cA + hstep, voffA);
        if (wr == 1) PG8_BAR;
        PG8_WAIT_V(4); PG8_BAR;
        PG8_STAGE(PG8_SB(1, 0), cB + kstep, voffB); PG8_STAGE(PG8_SA(1, 0), cA + kstep, voffA); PG8_STAGE(PG8_SB(1, 1), cB + hstep + kstep, voffB);
        PG8_WAIT_V(6); PG8_BAR;
    }
    for (;;) {
        const bool has_next = S.next(ui + 1, nxt);
        const char* nA = has_next ? (const char*)g.A + (size_t)nxt.pm * tstep : cA; const char* nB = has_next ? (const char*)g.Bt + (size_t)nxt.pn * tstep : cB;
        _Pragma("nounroll") for (int t = 0; t < nt; t += 2) {
            if constexpr (Epi::MIDK) { if (t == 8) E.midk(acc, cur, wr, fr); }
            const bool last = (t == nt - 2);
            const char* a1 = cA + (size_t)(t + 1) * kstep;
            const char* a2 = last ? nA : cA + (size_t)(t + 2) * kstep; const char* b2 = last ? nB : cB + (size_t)(t + 2) * kstep;
            const char* a3 = a2 + kstep; const char* b3 = b2 + kstep;
            if (last && has_next) S.a_ready(nxt);
            if constexpr (SP2) {
            PG8_LDB(B0, 0, 0); PG8_LDB(B1, 0, 1); PG8_SCHED; PG8_LDA(At, 0, 0); PG8_STAGE(PG8_SA(1, 1), a1 + hstep, voffA);
            PG8_WAIT_V(8); PG8_WAIT_L(0); PG8_BAR; PG8_MMA(0, 0, At, B0); PG8_MMA(0, 1, At, B1); PG8_BAR; PG8_SCHED;
            PG8_LDA(At, 0, 1); PG8_STAGE(PG8_SB(0, 0), b2, voffB); PG8_STAGE(PG8_SB(0, 1), b2 + hstep, voffB); PG8_STAGE(PG8_SA(0, 0), a2, voffA);
            PG8_WAIT_V(8); PG8_WAIT_L(0); PG8_BAR; PG8_MMA(1, 0, At, B0); PG8_MMA(1, 1, At, B1); PG8_BAR; PG8_SCHED;
            PG8_LDB(B0, 1, 0); PG8_LDB(B1, 1, 1); PG8_SCHED; PG8_LDA(At, 1, 0); PG8_STAGE(PG8_SA(0, 1), a2 + hstep, voffA);
            PG8_WAIT_V(8); PG8_WAIT_L(0); PG8_BAR; PG8_MMA(0, 0, At, B0); PG8_MMA(0, 1, At, B1); PG8_BAR; PG8_SCHED;
            PG8_LDA(At, 1, 1); PG8_STAGE(PG8_SB(1, 0), b3, voffB); PG8_STAGE(PG8_SB(1, 1), b3 + hstep, voffB); PG8_STAGE(PG8_SA(1, 0), a3, voffA);
            PG8_WAIT_V(8); PG8_WAIT_L(0); PG8_BAR; PG8_MMA(1, 0, At, B0); PG8_MMA(1, 1, At, B1); PG8_BAR; PG8_SCHED;
            } else {
            PG8_LDB(B0, 0, 0); PG8_SCHED; PG8_LDA(At, 0, 0); PG8_STAGE(PG8_SA(1, 1), a1 + hstep, voffA);
            PG8_WAIT_L(8); PG8_BAR; PG8_WAIT_L(0); PG8_MMA(0, 0, At, B0); PG8_BAR; PG8_SCHED;
            PG8_LDB(B1, 0, 1); PG8_STAGE(PG8_SB(0, 0), b2, voffB);
            PG8_BAR; PG8_WAIT_L(0); PG8_MMA(0, 1, At, B1); PG8_BAR;
            PG8_LDA(At, 0, 1); PG8_STAGE(PG8_SA(0, 0), a2, voffA);
            PG8_BAR; PG8_WAIT_L(0); PG8_MMA(1, 0, At, B0); PG8_BAR; PG8_SCHED;
            PG8_STAGE(PG8_SB(0, 1), b2 + hstep, voffB);
            PG8_WAIT_V(6); PG8_BAR; PG8_MMA(1, 1, At, B1); PG8_BAR;
            PG8_LDB(B0, 1, 0); PG8_SCHED; PG8_LDA(At, 1, 0); PG8_STAGE(PG8_SA(0, 1), a2 + hstep, voffA);
            PG8_WAIT_L(8); PG8_BAR; PG8_WAIT_L(0); PG8_MMA(0, 0, At, B0); PG8_BAR; PG8_SCHED;
            PG8_LDB(B1, 1, 1); PG8_STAGE(PG8_SB(1, 0), b3, voffB);
            PG8_BAR; PG8_WAIT_L(0); PG8_MMA(0, 1, At, B1); PG8_BAR;
            PG8_LDA(At, 1, 1); PG8_STAGE(PG8_SA(1, 0), a3, voffA);
            PG8_BAR; PG8_WAIT_L(0); PG8_MMA(1, 0, At, B0); PG8_BAR; PG8_SCHED;
            PG8_STAGE(PG8_SB(1, 1), b3 + hstep, voffB);
            PG8_WAIT_V(6); PG8_BAR; PG8_MMA(1, 1, At, B1); PG8_BAR;
            }
        }
        if constexpr (ALIGN_EPI) { if (wr == 0) PG8_BAR; }
        if constexpr (!Epi::AFTER_DRAIN) { E(acc, cur, wr, wc, fr, fq); S.done(cur); }
        if (!has_next) break;
#pragma unroll
        for (int a = 0; a < 2; ++a)
#pragma unroll
            for (int b = 0; b < 2; ++b)
#pragma unroll
                for (int m = 0; m < 4; ++m)
#pragma unroll
                    for (int n = 0; n < 2; ++n) acc[a][b][m][n] = (f32x4){0.f, 0.f, 0.f, 0.f};
        cur = nxt; cA = nA; cB = nB; ++ui;
        if constexpr (ALIGN_EPI) { if (wr == 1) PG8_BAR; }
    }
    PG8_WAIT_V(0);
    if constexpr (!ALIGN_EPI) { if (wr == 0) PG8_BAR; }
    PG8_BAR;
    if constexpr (Epi::AFTER_DRAIN) { E.fused(acc, cur, wr, wc, fr, fq, lds, wid, lane); S.done(cur); }
#undef PG8_SA
#undef PG8_SB
#undef PG8_STAGE
#undef PG8_LDA
#undef PG8_LDB
#undef PG8_MMA
#undef PG8_WAIT_V
#undef PG8_WAIT_L
#undef PG8_BAR
#undef PG8_SCHED
}
}

#ifndef REP_ATT
#define REP_ATT 1
#endif
#ifndef REP_P2
#define REP_P2 1
#endif
#ifndef REP_P1
#define REP_P1 1
#endif
#ifndef REP_P3
#define REP_P3 1
#endif
#ifndef REP_P5
#define REP_P5 1
#endif
#ifndef REP_P0
#define REP_P0 1
#endif
#ifndef GEMM_SP2
#define GEMM_SP2 true
#endif
#ifndef REP_P6
#define REP_P6 1
#endif
#ifndef EXTRA_SYNC
#define EXTRA_SYNC 0
#endif
constexpr int BATCH = 16, SEQ = 2048, DM = 1024, M = BATCH * SEQ, DFF = 2816, NMOD = 9 * DM;
constexpr float NORM_EPS = 1e-6f;
constexpr float LOG2E = 1.4426950408889634f;
constexpr float QSC_DIFF = 0.125f * LOG2E;
constexpr float QSC_MLA = 0.10206207261596577f * LOG2E;

constexpr size_t MiB = 1u << 20;
constexpr size_t WS_CTL = 0, WS_LAM = 4096, WS_MODF = 1 * MiB, WS_COSD = 2 * MiB, WS_SIND = 6 * MiB, WS_COSR = 10 * MiB, WS_SINR = 12 * MiB;
constexpr size_t WS_SSCQ = 14 * MiB, WS_SSCKV = 15 * MiB, WS_SSOM = 15 * MiB + 512 * 1024;
constexpr size_t WS_WGU1 = 16 * MiB, WS_WD1 = 27 * MiB, WS_WGU2 = 33 * MiB, WS_WD2 = 44 * MiB, WS_WIN = 50 * MiB, WS_WOUT = 55 * MiB, WS_WUQ = 57 * MiB, WS_WUKV = 58 * MiB;
constexpr size_t WS_U = 64 * MiB, WS_HID = 128 * MiB;
constexpr size_t WS_DQ = 128 * MiB, WS_DK = 160 * MiB, WS_DV = 192 * MiB, WS_CQ = 224 * MiB, WS_CKV = 248 * MiB, WS_KR = 264 * MiB, WS_MQ = 266 * MiB, WS_MK = 290 * MiB, WS_MV = 306 * MiB;
constexpr size_t WS_CV1 = 61 * MiB, WS_CV2 = 62 * MiB, WS_U3 = 338 * MiB, WS_HB = 402 * MiB, WS_END = 466 * MiB, WS_XBUF = 59 * MiB, WS_PCNT = 65536;
static_assert(WS_HID + (size_t)M * DFF * 2 <= WS_END && WS_MV + (size_t)M * 512 * 2 <= WS_END, "ws map");


__device__ __forceinline__ int lane_id() { int l; asm volatile("v_mbcnt_lo_u32_b32 %0, -1, 0\n\tv_mbcnt_hi_u32_b32 %0, -1, %0" : "=v"(l)); return l; }
namespace pg8 {
typedef unsigned u32x2 __attribute__((ext_vector_type(2)));
__device__ __forceinline__ u32x4 pack8(const f32x4 a, const f32x4 b) { u32x4 w; w.x = cvt_pk_bf16(a[0], a[1]); w.y = cvt_pk_bf16(a[2], a[3]); w.z = cvt_pk_bf16(b[0], b[1]); w.w = cvt_pk_bf16(b[2], b[3]); return w; }
__device__ __forceinline__ u32x2 pack4(const f32x4 a) { u32x2 w; w.x = cvt_pk_bf16(a[0], a[1]); w.y = cvt_pk_bf16(a[2], a[3]); return w; }
__device__ __forceinline__ float silu_f(float g) { return g * __builtin_amdgcn_rcpf(1.f + __builtin_amdgcn_exp2f(-LOG2E * g)); }
__device__ __forceinline__ float sumsq4(const f32x4 a) { return (a[0] * a[0] + a[1] * a[1]) + (a[2] * a[2] + a[3] * a[3]); }

__device__ __forceinline__ void deferred_norm_fixup(f32x4 (&acc)[2][2][4][2], const Unit& u, int wr, int wc, int fr, int fq, const float* ssh, const float* cv, int ncols) {
    const int row0 = u.pm * BM + wr * 64 + fr;
    const float* cb = cv + (size_t)(u.pm >> 3) * ncols + u.pn * BM + wc * 32 + 8 * fq;
    f32x4 c[2][2];
#pragma unroll
    for (int bj = 0; bj < 2; ++bj)
#pragma unroll
        for (int n = 0; n < 2; ++n) c[bj][n] = *(const f32x4*)(cb + bj * HALF + n * 4);
#pragma unroll
    for (int ai = 0; ai < 2; ++ai)
#pragma unroll
        for (int m = 0; m < 4; ++m) {
            const f32x4 st = *(const f32x4*)(ssh + (size_t)(row0 + ai * HALF + m * 16) * 4);
            const float r = __builtin_amdgcn_rsqf(((st[0] + st[1]) + (st[2] + st[3])) * (1.f / DM) + NORM_EPS);
#pragma unroll
            for (int bj = 0; bj < 2; ++bj)
#pragma unroll
                for (int n = 0; n < 2; ++n) acc[ai][bj][m][n] = acc[ai][bj][m][n] * r + c[bj][n];
            if (m == 3) asm volatile("" ::: "memory");
        }
}
template <bool DEFER> struct EpiSwiGLU {
    static constexpr bool PERM = true, AFTER_DRAIN = false, MIDK = false;
    bf16_t* O; int ldc; const float* ssh; const float* cv;
    __device__ __forceinline__ void operator()(f32x4 (&acc)[2][2][4][2], const Unit& u, int wr, int wc, int fr, int fq) const {
        if (DEFER) deferred_norm_fixup(acc, u, wr, wc, fr, fq, ssh, cv, 2 * DFF);
        const int row0 = u.pm * BM + wr * 64 + fr, col0 = u.pn * HALF + wc * 32 + 8 * fq;
#pragma unroll
        for (int ai = 0; ai < 2; ++ai)
#pragma unroll
            for (int m = 0; m < 4; ++m) {
                bf16_t* rowp = O + (size_t)(row0 + ai * HALF + m * 16) * ldc + col0;
                f32x4 h0, h1;
#pragma unroll
                for (int i = 0; i < 4; ++i) { h0[i] = silu_f(acc[ai][0][m][0][i]) * acc[ai][1][m][0][i]; h1[i] = silu_f(acc[ai][0][m][1][i]) * acc[ai][1][m][1][i]; }
                *(u32x4*)rowp = pack8(h0, h1);
            }
    }
};
struct EpiResid {
    static constexpr bool PERM = false, AFTER_DRAIN = false, MIDK = false;
    const float* base; float* out; const float* gate;
    __device__ __forceinline__ void operator()(const f32x4 (&acc)[2][2][4][2], const Unit& u, int wr, int wc, int fr, int fq) const {
        const int row0 = u.pm * BM + wr * 64 + fr, col0 = u.pn * BM + wc * 32 + 4 * fq;
        const float* gv = gate + (size_t)(u.pm >> 3) * NMOD + col0;
        f32x4 g[2][2];
#pragma unroll
        for (int bj = 0; bj < 2; ++bj)
#pragma unroll
            for (int n = 0; n < 2; ++n) g[bj][n] = *(const f32x4*)(gv + bj * HALF + n * 16);
#pragma unroll
        for (int ai = 0; ai < 2; ++ai)
#pragma unroll
            for (int m = 0; m < 4; ++m) {
                const size_t off = (size_t)(row0 + ai * HALF + m * 16) * DM + col0;
#pragma unroll
                for (int bj = 0; bj < 2; ++bj)
#pragma unroll
                    for (int n = 0; n < 2; ++n) { const f32x4 b = *(const f32x4*)(base + off + bj * HALF + n * 16); *(f32x4*)(out + off + bj * HALF + n * 16) = b + g[bj][n] * acc[ai][bj][m][n]; }
            }
    }
};
template <int FINAL, int BASE_BF16, int OUT_BF16, bool MIDK_ = false> struct EpiResidNorm {
    static constexpr bool PERM = true, AFTER_DRAIN = false, MIDK = MIDK_;
    const void* base_; void* out_; const float* modf; int gslot, sslot; bf16_t* U; const float* fn; float* xbuf; unsigned* cnt; unsigned want; PG8_LAS unsigned char* ldsx; const float* ssq;
    __device__ __forceinline__ void midk(f32x4 (&acc)[2][2][4][2], const Unit& u, int wr, int fr) const {
#pragma unroll
        for (int ai = 0; ai < 2; ++ai)
#pragma unroll
            for (int m = 0; m < 4; ++m) { const f32x4 s4 = *(const f32x4*)(ssq + (size_t)(u.pm * BM + ai * HALF + wr * 64 + m * 16 + fr) * 4);
                const float r = __builtin_amdgcn_rsqf(((s4[0] + s4[1]) + (s4[2] + s4[3])) * (1.f / 512.f) + NORM_EPS);
#pragma unroll
                for (int bj = 0; bj < 2; ++bj)
#pragma unroll
                    for (int n = 0; n < 2; ++n) acc[ai][bj][m][n] = acc[ai][bj][m][n] * r; }
    }
    __device__ __forceinline__ void operator()(f32x4 (&acc)[2][2][4][2], const Unit& u, int wr, int wc, int fr, int fq) const {
        const int row0 = u.pm * BM + wr * 64 + fr, col0 = u.pn * BM + wc * 32 + 8 * fq, rt0 = wr * 64 + fr;
        const float* mb = modf + (size_t)(u.pm >> 3) * NMOD + col0;
        if (!FINAL) {
            f32x4 g[2][2], av[2][2];
#pragma unroll
            for (int bj = 0; bj < 2; ++bj)
#pragma unroll
                for (int n = 0; n < 2; ++n) { g[bj][n] = *(const f32x4*)(mb + gslot * DM + bj * HALF + n * 4); av[bj][n] = *(const f32x4*)(mb + (sslot + 1) * DM + bj * HALF + n * 4); }
#pragma unroll
            for (int ai = 0; ai < 2; ++ai)
#pragma unroll
                for (int m = 0; m < 4; ++m) { const size_t off = (size_t)(row0 + ai * HALF + m * 16) * DM + col0; float ss = 0.f;
#pragma unroll
                    for (int bj = 0; bj < 2; ++bj) { f32x4 b0, b1;
                        if (BASE_BF16) { const u32x4 w = *(const u32x4*)((const bf16_t*)base_ + off + bj * HALF);
                            b0 = (f32x4){__uint_as_float(w.x << 16), __uint_as_float(w.x & 0xffff0000u), __uint_as_float(w.y << 16), __uint_as_float(w.y & 0xffff0000u)};
                            b1 = (f32x4){__uint_as_float(w.z << 16), __uint_as_float(w.z & 0xffff0000u), __uint_as_float(w.w << 16), __uint_as_float(w.w & 0xffff0000u)}; }
                        else { b0 = *(const f32x4*)((const float*)base_ + off + bj * HALF); b1 = *(const f32x4*)((const float*)base_ + off + bj * HALF + 4); }
                        const f32x4 h0 = b0 + g[bj][0] * acc[ai][bj][m][0], h1 = b1 + g[bj][1] * acc[ai][bj][m][1];
                        ss += sumsq4(h0) + sumsq4(h1);
                        *(u32x4*)((bf16_t*)out_ + off + bj * HALF) = pack8(h0, h1);
                        *(u32x4*)(U + off + bj * HALF) = pack8(h0 * av[bj][0], h1 * av[bj][1]); }
                    ss += __shfl_xor(ss, 16); ss += __shfl_xor(ss, 32);
                    if (fq == 0) ((PG8_LAS float*)ldsx)[(rt0 + ai * HALF + m * 16) * 4 + wc] = ss;
                    if (m & 1) asm volatile("" ::: "memory"); }
            asm volatile("s_waitcnt lgkmcnt(0)" ::: "memory"); __builtin_amdgcn_s_barrier(); asm volatile("" ::: "memory");
            { const int lane_ = lane_id(), wid_ = wr * 4 + wc, prow_ = wid_ * 32 + (lane_ & 31);
              if (lane_ < 32) { const f32x4 p4 = *(const PG8_LAS f32x4*)((PG8_LAS float*)ldsx + prow_ * 4); xbuf[(size_t)(u.pm * BM + prow_) * 4 + u.pn] = (p4[0] + p4[1]) + (p4[2] + p4[3]); } }
            asm volatile("s_waitcnt lgkmcnt(0)" ::: "memory"); __builtin_amdgcn_s_barrier(); asm volatile("" ::: "memory");
            return;
        }
        const int lane = lane_id(), wid = wr * 4 + wc;
        PG8_LAS float* P = (PG8_LAS float*)ldsx; PG8_LAS float* S = (PG8_LAS float*)(ldsx + 4096);
        {
            f32x4 g[2][2];
#pragma unroll
            for (int bj = 0; bj < 2; ++bj)
#pragma unroll
                for (int n = 0; n < 2; ++n) g[bj][n] = *(const f32x4*)(mb + gslot * DM + bj * HALF + n * 4);
            if (BASE_BF16) {
#pragma unroll
                for (int ai = 0; ai < 2; ++ai) {
                    u32x2 bb[4][2][2];
#pragma unroll
                    for (int m = 0; m < 4; ++m) { const size_t off = (size_t)(row0 + ai * HALF + m * 16) * DM + col0;
#pragma unroll
                        for (int bj = 0; bj < 2; ++bj)
#pragma unroll
                            for (int n = 0; n < 2; ++n) bb[m][bj][n] = *(const u32x2*)((const bf16_t*)base_ + off + bj * HALF + n * 4); }
#pragma unroll
                    for (int m = 0; m < 4; ++m) { float ss = 0.f;
#pragma unroll
                        for (int bj = 0; bj < 2; ++bj)
#pragma unroll
                            for (int n = 0; n < 2; ++n) { const u32x2 w = bb[m][bj][n];
                                const f32x4 b = (f32x4){__uint_as_float(w.x << 16), __uint_as_float(w.x & 0xffff0000u), __uint_as_float(w.y << 16), __uint_as_float(w.y & 0xffff0000u)};
                                const f32x4 h = b + g[bj][n] * acc[ai][bj][m][n]; acc[ai][bj][m][n] = h; ss += sumsq4(h); }
                        ss += __shfl_xor(ss, 16); ss += __shfl_xor(ss, 32);
                        if (fq == 0) P[(rt0 + ai * HALF + m * 16) * 4 + wc] = ss; }
                    asm volatile("" ::: "memory");
                }
            } else {
#pragma unroll
                for (int ai = 0; ai < 2; ++ai)
#pragma unroll
                    for (int m = 0; m < 4; ++m) { const size_t off = (size_t)(row0 + ai * HALF + m * 16) * DM + col0; float ss = 0.f;
#pragma unroll
                        for (int bj = 0; bj < 2; ++bj)
#pragma unroll
                            for (int n = 0; n < 2; ++n) { const f32x4 b = *(const f32x4*)((const float*)base_ + off + bj * HALF + n * 4); const f32x4 h = b + g[bj][n] * acc[ai][bj][m][n]; acc[ai][bj][m][n] = h; ss += sumsq4(h); }
                        ss += __shfl_xor(ss, 16); ss += __shfl_xor(ss, 32);
                        if (fq == 0) P[(rt0 + ai * HALF + m * 16) * 4 + wc] = ss;
                        if (m & 1) asm volatile("" ::: "memory"); }
            }
        }
        asm volatile("s_waitcnt lgkmcnt(0)" ::: "memory"); __builtin_amdgcn_s_barrier(); asm volatile("" ::: "memory");
        const int prow = wid * 32 + (lane & 31);
        float* slot = xbuf + ((size_t)(u.pm * BM + prow) * 4);
        if (lane < 32) { const f32x4 p4 = *(const PG8_LAS f32x4*)(P + prow * 4); __hip_atomic_store(slot + u.pn, (p4[0] + p4[1]) + (p4[2] + p4[3]), __ATOMIC_RELAXED, __HIP_MEMORY_SCOPE_AGENT); }
        asm volatile("s_waitcnt vmcnt(0)" ::: "memory");
        unsigned* cw = cnt + 64 * u.pm;
        if (lane == 0) __hip_atomic_fetch_add(cw, 1u, __ATOMIC_RELAXED, __HIP_MEMORY_SCOPE_AGENT);
        { unsigned sp = 0;
          while ((unsigned)__builtin_amdgcn_readfirstlane(__hip_atomic_load(cw, __ATOMIC_RELAXED, __HIP_MEMORY_SCOPE_AGENT)) < want) { __builtin_amdgcn_s_sleep(1); if (++sp > (1u << 22)) break; } }
        __builtin_amdgcn_fence(__ATOMIC_ACQUIRE, "agent");
        if (lane < 32) {
            const unsigned long long w0 = __hip_atomic_load((const unsigned long long*)slot, __ATOMIC_RELAXED, __HIP_MEMORY_SCOPE_AGENT), w1 = __hip_atomic_load((const unsigned long long*)slot + 1, __ATOMIC_RELAXED, __HIP_MEMORY_SCOPE_AGENT);
            const float s = (__uint_as_float((unsigned)w0) + __uint_as_float((unsigned)(w0 >> 32))) + (__uint_as_float((unsigned)w1) + __uint_as_float((unsigned)(w1 >> 32)));
            S[prow] = __builtin_amdgcn_rsqf(s * (1.f / DM) + NORM_EPS);
        }
        f32x4 av[2][2], sv[2][2];
#pragma unroll
        for (int bj = 0; bj < 2; ++bj)
#pragma unroll
            for (int n = 0; n < 2; ++n) {
                if (FINAL) { av[bj][n] = *(const f32x4*)(fn + col0 + bj * HALF + n * 4); sv[bj][n] = (f32x4){0.f, 0.f, 0.f, 0.f}; }
                else { av[bj][n] = *(const f32x4*)(mb + (sslot + 1) * DM + bj * HALF + n * 4); sv[bj][n] = *(const f32x4*)(mb + sslot * DM + bj * HALF + n * 4); } }
        asm volatile("s_waitcnt lgkmcnt(0)" ::: "memory"); __builtin_amdgcn_s_barrier(); asm volatile("" ::: "memory");
#pragma unroll
        for (int ai = 0; ai < 2; ++ai)
#pragma unroll
            for (int m = 0; m < 4; ++m) {
                const size_t off = (size_t)(row0 + ai * HALF + m * 16) * DM + col0; const float r = S[rt0 + ai * HALF + m * 16];
#pragma unroll
                for (int bj = 0; bj < 2; ++bj)
#pragma unroll
                    for (int n = 0; n < 2; ++n) { const f32x4 h = acc[ai][bj][m][n];
                        if (FINAL) { *(f32x4*)((float*)out_ + off + bj * HALF + n * 4) = h * r * av[bj][n]; }
                        else { if (OUT_BF16) *(u32x2*)((bf16_t*)out_ + off + bj * HALF + n * 4) = pack4(h); else *(f32x4*)((float*)out_ + off + bj * HALF + n * 4) = h;
                               *(u32x2*)(U + off + bj * HALF + n * 4) = pack4(h * r * av[bj][n] + sv[bj][n]); } }
            }
        asm volatile("s_waitcnt lgkmcnt(0)" ::: "memory"); __builtin_amdgcn_s_barrier(); asm volatile("" ::: "memory");
    }
};
struct EpiProj {
    static constexpr bool PERM = true, AFTER_DRAIN = false, MIDK = false;
    unsigned char* ws;
    __device__ __forceinline__ void operator()(f32x4 (&acc)[2][2][4][2], const Unit& u, int wr, int wc, int fr, int fq) const {
        asm volatile("" : "+v"(fr), "+v"(fq));
        deferred_norm_fixup(acc, u, wr, wc, fr, fq, (const float*)(ws + WS_XBUF), (const float*)(ws + WS_CV1), 2304);
        const int pn = u.pn, row0 = u.pm * BM + wr * 64 + fr;
        bf16_t* const DQ = (bf16_t*)(ws + WS_DQ); bf16_t* const DK = (bf16_t*)(ws + WS_DK); bf16_t* const DV = (bf16_t*)(ws + WS_DV); bf16_t* const CQ = (bf16_t*)(ws + WS_CQ); bf16_t* const CKV = (bf16_t*)(ws + WS_CKV); bf16_t* const KR = (bf16_t*)(ws + WS_KR);
        float* const SSCQ = (float*)(ws + WS_SSCQ); float* const SSCKV = (float*)(ws + WS_SSCKV);
        const float* const COSD = (const float*)(ws + WS_COSD); const float* const SIND = (const float*)(ws + WS_SIND); const float* const COSR = (const float*)(ws + WS_COSR); const float* const SINR = (const float*)(ws + WS_SINR);
        if (pn < 4) {
            bf16_t* dst = (pn < 2) ? DQ : DK; const float sc = (pn < 2) ? QSC_DIFF : 1.f; const int colb = 256 * (pn & 1) + 64 * wc + 8 * fq;
#pragma unroll
            for (int ai = 0; ai < 2; ++ai)
#pragma unroll
                for (int m = 0; m < 4; ++m) {
                    const int row = row0 + ai * HALF + m * 16;
                    const f32x4 c0 = *(const f32x4*)(COSD + (size_t)row * 32 + 8 * fq), c1 = *(const f32x4*)(COSD + (size_t)row * 32 + 8 * fq + 4);
                    const f32x4 s0 = *(const f32x4*)(SIND + (size_t)row * 32 + 8 * fq), s1 = *(const f32x4*)(SIND + (size_t)row * 32 + 8 * fq + 4);
                    const f32x4 x1a = acc[ai][0][m][0], x1b = acc[ai][0][m][1], x2a = acc[ai][1][m][0], x2b = acc[ai][1][m][1];
                    const f32x4 y1a = (x1a * c0 - x2a * s0) * sc, y1b = (x1b * c1 - x2b * s1) * sc, y2a = (x2a * c0 + x1a * s0) * sc, y2b = (x2b * c1 + x1b * s1) * sc;
                    bf16_t* rp = dst + (size_t)row * 512 + colb;
                    *(u32x4*)rp = pack8(y1a, y1b); *(u32x4*)(rp + 32) = pack8(y2a, y2b);
                    asm volatile("" ::: "memory");
                }
        } else if (pn < 6) {
            const int colb = 256 * (pn - 4) + 32 * wc + 8 * fq;
#pragma unroll
            for (int ai = 0; ai < 2; ++ai)
#pragma unroll
                for (int m = 0; m < 4; ++m) { bf16_t* rp = DV + (size_t)(row0 + ai * HALF + m * 16) * 512 + colb;
#pragma unroll
                    for (int bj = 0; bj < 2; ++bj) *(u32x4*)(rp + bj * HALF) = pack8(acc[ai][bj][m][0], acc[ai][bj][m][1]); }
        } else if (pn == 6) {
            const int colb = 32 * wc + 8 * fq;
#pragma unroll
            for (int ai = 0; ai < 2; ++ai)
#pragma unroll
                for (int m = 0; m < 4; ++m) { const int row = row0 + ai * HALF + m * 16; bf16_t* rp = CQ + (size_t)row * 384 + colb; float ss = 0.f;
#pragma unroll
                    for (int bj = 0; bj < 2; ++bj) { *(u32x4*)(rp + bj * HALF) = pack8(acc[ai][bj][m][0], acc[ai][bj][m][1]); ss += sumsq4(acc[ai][bj][m][0]) + sumsq4(acc[ai][bj][m][1]); }
                    ss += __shfl_xor(ss, 16); ss += __shfl_xor(ss, 32); if (fq == 0) SSCQ[(size_t)row * 8 + wc] = ss; }
        } else if (pn == 7) {
#pragma unroll
            for (int ai = 0; ai < 2; ++ai)
#pragma unroll
                for (int m = 0; m < 4; ++m) { const int row = row0 + ai * HALF + m * 16; bf16_t* rp = CQ + (size_t)row * 384 + 256 + 32 * wc + 8 * fq;
                    *(u32x4*)rp = pack8(acc[ai][0][m][0], acc[ai][0][m][1]); float ss = sumsq4(acc[ai][0][m][0]) + sumsq4(acc[ai][0][m][1]);
                    ss += __shfl_xor(ss, 16); ss += __shfl_xor(ss, 32); if (fq == 0) SSCQ[(size_t)row * 8 + 4 + wc] = ss;
                    if (wc == 0) {
                        const f32x4 c = *(const f32x4*)(COSR + (size_t)row * 16 + 4 * fq), s = *(const f32x4*)(SINR + (size_t)row * 16 + 4 * fq);
                        const f32x4 x1 = acc[ai][1][m][0], x2 = acc[ai][1][m][1];
                        bf16_t* kp = KR + (size_t)row * 32 + 4 * fq;
                        *(u32x2*)kp = pack4(x1 * c - x2 * s); *(u32x2*)(kp + 16) = pack4(x2 * c + x1 * s);
                    } }
        } else {
            const int colb = 32 * wc + 8 * fq;
#pragma unroll
            for (int ai = 0; ai < 2; ++ai)
#pragma unroll
                for (int m = 0; m < 4; ++m) { const int row = row0 + ai * HALF + m * 16; bf16_t* rp = CKV + (size_t)row * 256 + colb; float ss = 0.f;
#pragma unroll
                    for (int bj = 0; bj < 2; ++bj) { *(u32x4*)(rp + bj * HALF) = pack8(acc[ai][bj][m][0], acc[ai][bj][m][1]); ss += sumsq4(acc[ai][bj][m][0]) + sumsq4(acc[ai][bj][m][1]); }
                    ss += __shfl_xor(ss, 16); ss += __shfl_xor(ss, 32); if (fq == 0) SSCKV[(size_t)row * 4 + wc] = ss; }
        }
    }
};
struct EpiUq {
    static constexpr bool PERM = true, AFTER_DRAIN = false, MIDK = false;
    unsigned char* ws;
    __device__ __forceinline__ void operator()(const f32x4 (&acc)[2][2][4][2], const Unit& u, int wr, int wc, int fr, int fq) const {
        const int pn = u.pn, row0 = u.pm * BM + wr * 64 + fr;
        bf16_t* const MQ = (bf16_t*)(ws + WS_MQ); const float* const SSCQ = (const float*)(ws + WS_SSCQ); const float* const COSR = (const float*)(ws + WS_COSR); const float* const SINR = (const float*)(ws + WS_SINR);
#pragma unroll
        for (int ai = 0; ai < 2; ++ai)
#pragma unroll
            for (int m = 0; m < 4; ++m) { const int row = row0 + ai * HALF + m * 16;
                const f32x4 sa = *(const f32x4*)(SSCQ + (size_t)row * 8), sb = *(const f32x4*)(SSCQ + (size_t)row * 8 + 4);
                const float ssq = ((sa[0] + sa[1]) + (sa[2] + sa[3])) + ((sb[0] + sb[1]) + (sb[2] + sb[3]));
                const float r = __builtin_amdgcn_rsqf(ssq * (1.f / 384.f) + NORM_EPS) * QSC_MLA;
                bf16_t* hp = MQ + (size_t)row * 384 + (2 * pn + (wc >> 1)) * 96 + 32 * (wc & 1) + 8 * fq;
                *(u32x4*)hp = pack8(acc[ai][0][m][0] * r, acc[ai][0][m][1] * r);
                if (wc < 2) {
                    const f32x4 c = *(const f32x4*)(COSR + (size_t)row * 16 + 4 * fq), s = *(const f32x4*)(SINR + (size_t)row * 16 + 4 * fq);
                    const f32x4 x1 = acc[ai][1][m][0] * r, x2 = acc[ai][1][m][1] * r;
                    bf16_t* rp = MQ + (size_t)row * 384 + (2 * pn + wc) * 96 + 64 + 4 * fq;
                    *(u32x2*)rp = pack4(x1 * c - x2 * s); *(u32x2*)(rp + 16) = pack4(x2 * c + x1 * s);
                }
                asm volatile("" ::: "memory"); }
    }
};
struct EpiUkv {
    static constexpr bool PERM = true, AFTER_DRAIN = false, MIDK = false;
    unsigned char* ws;
    __device__ __forceinline__ void operator()(const f32x4 (&acc)[2][2][4][2], const Unit& u, int wr, int wc, int fr, int fq) const {
        const int pn = u.pn, row0 = u.pm * BM + wr * 64 + fr;
        bf16_t* const MK = (bf16_t*)(ws + WS_MK); bf16_t* const MV = (bf16_t*)(ws + WS_MV); const float* const SSCKV = (const float*)(ws + WS_SSCKV);
#pragma unroll
        for (int ai = 0; ai < 2; ++ai)
#pragma unroll
            for (int m = 0; m < 4; ++m) { const int row = row0 + ai * HALF + m * 16;
                const f32x4 sa = *(const f32x4*)(SSCKV + (size_t)row * 4);
                const float r = __builtin_amdgcn_rsqf(((sa[0] + sa[1]) + (sa[2] + sa[3])) * (1.f / 256.f) + NORM_EPS);
                bf16_t* rp = (pn == 0) ? (MK + (size_t)row * 256 + 32 * wc + 8 * fq) : (MV + (size_t)row * 512 + 256 * (pn - 1) + 32 * wc + 8 * fq);
#pragma unroll
                for (int bj = 0; bj < 2; ++bj) *(u32x4*)(rp + bj * HALF) = pack8(acc[ai][bj][m][0] * r, acc[ai][bj][m][1] * r);
                asm volatile("" ::: "memory"); }
    }
};
}

#define LAS __attribute__((address_space(3)))
namespace att {
typedef unsigned short bf16_t;
typedef short bf16x8 __attribute__((ext_vector_type(8)));
typedef short s16x4 __attribute__((ext_vector_type(4)));
typedef float f32x16 __attribute__((ext_vector_type(16)));
typedef float f32x4 __attribute__((ext_vector_type(4)));
typedef unsigned u32x4 __attribute__((ext_vector_type(4)));
typedef unsigned u32x2 __attribute__((ext_vector_type(2)));
constexpr int KBUF = 13312, VBUF = 16384, KOFF = 0, VOFF = 2 * KBUF, ATT_LDS = VOFF + 2 * VBUF;
__device__ __forceinline__ int crow(int r, int hi) { return (r & 3) + 8 * (r >> 2) + 4 * hi; }
__device__ __forceinline__ unsigned cvtpk(float lo, float hi) { unsigned r; asm volatile("v_cvt_pk_bf16_f32 %0, %1, %2" : "=v"(r) : "v"(lo), "v"(hi)); return r; }
__device__ __forceinline__ s16x4 vtr(const LAS unsigned char* p) { return __builtin_bit_cast(s16x4, __builtin_amdgcn_ds_read_tr16_b64_v4i16((LAS s16x4*)p)); }

__device__ __forceinline__ void glds16(const void* gsrc, unsigned lds_dst) { unsigned keep;
    asm volatile("s_mov_b32 %0, m0\n\ts_mov_b32 m0, %2\n\ts_nop 0\n\tglobal_load_lds_dwordx4 %1, off\n\ts_mov_b32 m0, %0" : "=&s"(keep) : "v"(gsrc), "s"(lds_dst) : "memory"); }
struct PassArgs { const bf16_t* Q; int pq; const bf16_t* K1; int pk1; const bf16_t* K2; int pk2; const bf16_t* V; int pv; };

template <int DQK>
__device__ __forceinline__ void flash_pass(f32x16 (&o)[4], float& l_out, const PassArgs& a, int q0, LAS unsigned char* lds, int tid, int wid, int lane) {
    const int r32 = lane & 31, hi = lane >> 5;
    bf16x8 qr[DQK / 16];
    { const bf16_t* qp = a.Q + (size_t)(q0 + wid * 32 + r32) * a.pq + hi * 8;
#pragma unroll
      for (int d0 = 0; d0 < DQK / 16; ++d0) qr[d0] = *(const bf16x8*)(qp + d0 * 16); }
    const unsigned kgo0 = (unsigned)(lane * a.pk1 + wid * 8) * 2u, kgo1 = (unsigned)(lane * a.pk2 + (wid & 3) * 8) * 2u;
    const size_t kstep0 = (size_t)(64 * a.pk1) * 2, kstep1 = (size_t)(64 * a.pk2) * 2, vstep = (size_t)(64 * a.pv) * 2;
    unsigned vgo[2];
#pragma unroll
    for (int i = 0; i < 2; ++i) { const int p = wid + 8 * i; vgo[i] = (unsigned)((16 * (p & 3) + (lane >> 2)) * a.pv + (4 * (p >> 2) + (lane & 3)) * 8) * 2u; }
    const int NT = (q0 + 256) >> 6;
    const int wq_lo = q0 + wid * 32, qrow = wq_lo + r32;
    float m_ref = -1e30f, l_run = 0.f;
#pragma unroll
    for (int db = 0; db < 4; ++db)
#pragma unroll
        for (int r = 0; r < 16; ++r) o[db][r] = 0.f;
    const unsigned kfo = (unsigned)(hi * 1024 + r32 * 16);
    const unsigned vfo = (unsigned)((4 * hi + ((lane & 15) >> 2)) * 64 + ((lane >> 4) & 1) * 32 + (lane & 3) * 8);
#define ATT_GLDS(g, l) glds16((const void*)(g), (unsigned)__builtin_amdgcn_readfirstlane((int)(unsigned)(uintptr_t)(l)))
#define ATT_DMAK(t, b) do { ATT_GLDS((const char*)a.K1 + (size_t)(t) * kstep0 + kgo0, lds + KOFF + (b) * KBUF + wid * 1024); \
        if (DQK == 96 && wid < 4) ATT_GLDS((const char*)a.K2 + (size_t)(t) * kstep1 + kgo1, lds + KOFF + (b) * KBUF + (8 + wid) * 1024); } while (0)
#define ATT_DMAV(t, b) do { _Pragma("unroll") for (int i = 0; i < 2; ++i) ATT_GLDS((const char*)a.V + (size_t)(t) * vstep + vgo[i], lds + VOFF + (b) * VBUF + (wid + 8 * i) * 1024); } while (0)
#define ATT_SYNC() do { asm volatile("s_waitcnt vmcnt(0)" ::: "memory"); __syncthreads(); } while (0)
#define ATT_SB() __builtin_amdgcn_sched_barrier(0)
#define ATT_KRD(dst, kb_, d0) do { dst[0] = *(const LAS bf16x8*)(kb_ + (d0) * 2048); dst[1] = *(const LAS bf16x8*)(kb_ + (d0) * 2048 + 512); } while (0)
#define ATT_KMM(P0, P1, src, d0) do { \
        if ((d0) == 0) { P0 = __builtin_amdgcn_mfma_f32_32x32x16_bf16(src[0], qr[d0], zero16, 0, 0, 0); P1 = __builtin_amdgcn_mfma_f32_32x32x16_bf16(src[1], qr[d0], zero16, 0, 0, 0); } \
        else { P0 = __builtin_amdgcn_mfma_f32_32x32x16_bf16(src[0], qr[d0], P0, 0, 0, 0); P1 = __builtin_amdgcn_mfma_f32_32x32x16_bf16(src[1], qr[d0], P1, 0, 0, 0); } } while (0)
#define ATT_QK(P0, P1, b) do { const LAS unsigned char* kb_ = lds + KOFF + (b) * KBUF + kfo; bf16x8 ka_[2], kc_[2]; \
        ATT_KRD(ka_, kb_, 0); ATT_SB(); ATT_KRD(kc_, kb_, 1); ATT_SB(); ATT_KMM(P0, P1, ka_, 0); ATT_SB(); \
        ATT_KRD(ka_, kb_, 2); ATT_SB(); ATT_KMM(P0, P1, kc_, 1); ATT_SB(); \
        ATT_KRD(kc_, kb_, 3); ATT_SB(); ATT_KMM(P0, P1, ka_, 2); ATT_SB(); \
        if (DQK == 96) { ATT_KRD(ka_, kb_, 4); ATT_SB(); } \
        ATT_KMM(P0, P1, kc_, 3); ATT_SB(); \
        if (DQK == 96) { ATT_KRD(kc_, kb_, 5); ATT_SB(); ATT_KMM(P0, P1, ka_, 4); ATT_SB(); ATT_KMM(P0, P1, kc_, 5); ATT_SB(); } } while (0)
#define ATT_VRD(dst, vb_, j) do { _Pragma("unroll") for (int s_ = 0; s_ < 2; ++s_) { dst[2 * s_] = vtr(vb_ + (((j) >> 1) * 4 + 2 * ((j) & 1) + s_) * 1024); dst[2 * s_ + 1] = vtr(vb_ + (((j) >> 1) * 4 + 2 * ((j) & 1) + s_) * 1024 + 512); } } while (0)
#define ATT_VMM(PW, src, j) do { _Pragma("unroll") for (int s_ = 0; s_ < 2; ++s_) { \
        const bf16x8 vf_ = (bf16x8){src[2 * s_][0], src[2 * s_][1], src[2 * s_][2], src[2 * s_][3], src[2 * s_ + 1][0], src[2 * s_ + 1][1], src[2 * s_ + 1][2], src[2 * s_ + 1][3]}; \
        o[(j) >> 1] = __builtin_amdgcn_mfma_f32_32x32x16_bf16(vf_, __builtin_bit_cast(bf16x8, PW[2 * ((j) & 1) + s_]), o[(j) >> 1], 0, 0, 0); } } while (0)
#define ATT_PV(PW, b) do { const LAS unsigned char* vb_ = lds + VOFF + (b) * VBUF + vfo; s16x4 va_[4], vc_[4]; \
        ATT_VRD(va_, vb_, 0); ATT_SB(); \
        ATT_VRD(vc_, vb_, 1); ATT_SB(); ATT_VMM(PW, va_, 0); ATT_SB(); ATT_VRD(va_, vb_, 2); ATT_SB(); ATT_VMM(PW, vc_, 1); ATT_SB(); \
        ATT_VRD(vc_, vb_, 3); ATT_SB(); ATT_VMM(PW, va_, 2); ATT_SB(); ATT_VRD(va_, vb_, 4); ATT_SB(); ATT_VMM(PW, vc_, 3); ATT_SB(); \
        ATT_VRD(vc_, vb_, 5); ATT_SB(); ATT_VMM(PW, va_, 4); ATT_SB(); ATT_VRD(va_, vb_, 6); ATT_SB(); ATT_VMM(PW, vc_, 5); ATT_SB(); \
        ATT_VRD(vc_, vb_, 7); ATT_SB(); ATT_VMM(PW, va_, 6); ATT_SB(); ATT_VMM(PW, vc_, 7); ATT_SB(); } while (0)
#define ATT_SOFTMAX(t, P0, P1, PW) do { \
        if (64 * (t) + 63 > wq_lo) { const int kb0_ = 64 * (t) + 4 * hi; \
            _Pragma("unroll") for (int r = 0; r < 16; ++r) { const int kv_ = kb0_ + (r & 3) + 8 * (r >> 2); if (kv_ > qrow) P0[r] = -1e30f; if (kv_ + 32 > qrow) P1[r] = -1e30f; } } \
        float mx_ = fmaxf(P0[0], P1[0]); \
        _Pragma("unroll") for (int r = 1; r < 16; ++r) mx_ = fmaxf(mx_, fmaxf(P0[r], P1[r])); \
        mx_ = fmaxf(mx_, __shfl_xor(mx_, 32)); \
        if (__any(mx_ > m_ref + 8.f)) { const float mn_ = fmaxf(m_ref, mx_), al_ = __builtin_amdgcn_exp2f(m_ref - mn_); m_ref = mn_; l_run *= al_; \
            _Pragma("unroll") for (int db = 0; db < 4; ++db) _Pragma("unroll") for (int r = 0; r < 16; ++r) o[db][r] *= al_; } \
        float rs_ = 0.f; \
        _Pragma("unroll") for (int r = 0; r < 16; ++r) { P0[r] = __builtin_amdgcn_exp2f(P0[r] - m_ref); P1[r] = __builtin_amdgcn_exp2f(P1[r] - m_ref); rs_ += P0[r] + P1[r]; } \
        l_run += rs_; \
        _Pragma("unroll") for (int j = 0; j < 4; ++j) { PW[0][j] = cvtpk(P0[2 * j], P0[2 * j + 1]); PW[1][j] = cvtpk(P0[8 + 2 * j], P0[9 + 2 * j]); PW[2][j] = cvtpk(P1[2 * j], P1[2 * j + 1]); PW[3][j] = cvtpk(P1[8 + 2 * j], P1[9 + 2 * j]); } } while (0)
#define ATT_NEED(t) (64 * (t) <= wq_lo + 31)
#define ATT_MXC(P0, P1, j) do { mxa_ = __builtin_fmaxf(__builtin_fmaxf(mxa_, P0[2 * (j)]), P0[2 * (j) + 1]); mxb_ = __builtin_fmaxf(__builtin_fmaxf(mxb_, P1[2 * (j)]), P1[2 * (j) + 1]); } while (0)
#define ATT_EXC(P0, P1, PW, c) do { _Pragma("unroll") for (int r = 4 * (c); r < 4 * (c) + 4; ++r) { P0[r] = __builtin_amdgcn_exp2f(P0[r] - m_ref); P1[r] = __builtin_amdgcn_exp2f(P1[r] - m_ref); rs_ += P0[r] + P1[r]; } \
        PW[(c) >> 1][2 * ((c) & 1)] = cvtpk(P0[4 * (c)], P0[4 * (c) + 1]); PW[(c) >> 1][2 * ((c) & 1) + 1] = cvtpk(P0[4 * (c) + 2], P0[4 * (c) + 3]); \
        PW[2 + ((c) >> 1)][2 * ((c) & 1)] = cvtpk(P1[4 * (c)], P1[4 * (c) + 1]); PW[2 + ((c) >> 1)][2 * ((c) & 1) + 1] = cvtpk(P1[4 * (c) + 2], P1[4 * (c) + 3]); } while (0)
#define ATT_FAST(SE0, SE1, SO0, SO1, PAR) do { \
        { const LAS unsigned char* vb_ = lds + VOFF + (1 - (PAR)) * VBUF + vfo; s16x4 va_[4], vc_[4]; float mxa_ = -3.0e38f, mxb_ = -3.0e38f; \
          ATT_VRD(va_, vb_, 0); ATT_SB(); \
          ATT_VRD(vc_, vb_, 1); ATT_SB(); ATT_VMM(pwa, va_, 0); ATT_MXC(SE0, SE1, 0); ATT_SB(); ATT_VRD(va_, vb_, 2); ATT_SB(); ATT_VMM(pwa, vc_, 1); ATT_MXC(SE0, SE1, 1); ATT_SB(); \
          ATT_VRD(vc_, vb_, 3); ATT_SB(); ATT_VMM(pwa, va_, 2); ATT_MXC(SE0, SE1, 2); ATT_SB(); ATT_VRD(va_, vb_, 4); ATT_SB(); ATT_VMM(pwa, vc_, 3); ATT_MXC(SE0, SE1, 3); ATT_SB(); \
          ATT_VRD(vc_, vb_, 5); ATT_SB(); ATT_VMM(pwa, va_, 4); ATT_MXC(SE0, SE1, 4); ATT_SB(); ATT_VRD(va_, vb_, 6); ATT_SB(); ATT_VMM(pwa, vc_, 5); ATT_MXC(SE0, SE1, 5); ATT_SB(); \
          ATT_VRD(vc_, vb_, 7); ATT_SB(); ATT_VMM(pwa, va_, 6); ATT_MXC(SE0, SE1, 6); ATT_SB(); ATT_VMM(pwa, vc_, 7); ATT_MXC(SE0, SE1, 7); ATT_SB(); \
          float mx_ = __builtin_fmaxf(mxa_, mxb_); \
          { auto rr_ = __builtin_amdgcn_permlane32_swap(__float_as_uint(mx_), __float_as_uint(mx_), false, false); mx_ = __builtin_fmaxf(__uint_as_float(rr_[0]), __uint_as_float(rr_[1])); } \
          if (__any(mx_ > m_ref + 8.f)) { const float mn_ = fmaxf(m_ref, mx_), al_ = __builtin_amdgcn_exp2f(m_ref - mn_); m_ref = mn_; l_run *= al_; \
              _Pragma("unroll") for (int db = 0; db < 4; ++db) _Pragma("unroll") for (int r = 0; r < 16; ++r) o[db][r] *= al_; } } \
        { const LAS unsigned char* kb_ = lds + KOFF + (1 - (PAR)) * KBUF + kfo; bf16x8 ka_[2], kc_[2]; float rs_ = 0.f; \
          ATT_KRD(ka_, kb_, 0); ATT_SB(); ATT_KRD(kc_, kb_, 1); ATT_SB(); ATT_KMM(SO0, SO1, ka_, 0); ATT_EXC(SE0, SE1, pwa, 0); ATT_SB(); \
          ATT_KRD(ka_, kb_, 2); ATT_SB(); ATT_KMM(SO0, SO1, kc_, 1); ATT_EXC(SE0, SE1, pwa, 1); ATT_SB(); \
          ATT_KRD(kc_, kb_, 3); ATT_SB(); ATT_KMM(SO0, SO1, ka_, 2); ATT_EXC(SE0, SE1, pwa, 2); ATT_SB(); \
          if (DQK == 96) { ATT_KRD(ka_, kb_, 4); ATT_SB(); } \
          ATT_KMM(SO0, SO1, kc_, 3); ATT_EXC(SE0, SE1, pwa, 3); ATT_SB(); \
          if (DQK == 96) { ATT_KRD(kc_, kb_, 5); ATT_SB(); ATT_KMM(SO0, SO1, ka_, 4); ATT_SB(); ATT_KMM(SO0, SO1, kc_, 5); ATT_SB(); } \
          l_run += rs_; } } while (0)
#define ATT_IVAL(GRP, t, PAR, SE0, SE1, SO0, SO1) do { \
        if ((t) < NT) { if ((t) + 2 < NT) ATT_DMAK((t) + 2, PAR); ATT_DMAV(t, PAR); } \
        if (GRP == 0) { \
            if ((t) + 1 < NT && ATT_NEED((t) + 1)) ATT_QK(SO0, SO1, 1 - (PAR)); \
            if ((t) >= 1 && ATT_NEED((t) - 1)) ATT_PV(pwa, 1 - (PAR)); \
            if ((t) < NT && ATT_NEED(t)) ATT_SOFTMAX(t, SE0, SE1, pwa); \
        } else { \
            if ((t) >= 1 && ATT_NEED((t) - 1)) { ATT_SOFTMAX((t) - 1, SO0, SO1, pwa); ATT_PV(pwa, 1 - (PAR)); } \
            if ((t) + 1 < NT && ATT_NEED((t) + 1)) ATT_QK(SO0, SO1, 1 - (PAR)); \
        } \
        ATT_SYNC(); } while (0)
    f32x16 sa0, sa1, sb0, sb1; u32x4 pwa[4]; f32x16 zero16;
#pragma unroll
    for (int r = 0; r < 16; ++r) zero16[r] = 0.f;
#pragma unroll
    for (int j = 0; j < 4; ++j) pwa[j] = (u32x4){0u, 0u, 0u, 0u};
#ifdef T_GRP
    const int grp = T_GRP;
#else
    const int grp = wid >> 2;
#endif
    ATT_DMAK(0, 0); ATT_DMAK(1, 1); ATT_SYNC();
    ATT_QK(sa0, sa1, 0);
    __syncthreads();
    (void)grp;
#define ATT_FIVAL(t, PAR, SE0, SE1, SO0, SO1) do { if ((t) + 2 < NT) ATT_DMAK((t) + 2, PAR); ATT_DMAV(t, PAR); ATT_FAST(SE0, SE1, SO0, SO1, PAR); ATT_SYNC(); } while (0)
    const int tfmax = (wq_lo >= 127) ? ((wq_lo - 63) >> 6) - 1 : 0;
    ATT_IVAL(0, 0, 0, sa0, sa1, sb0, sb1);
    int t = 1;
    for (; t + 1 <= tfmax; t += 2) {
        ATT_FIVAL(t, 1, sb0, sb1, sa0, sa1);
        ATT_FIVAL(t + 1, 0, sa0, sa1, sb0, sb1);
    }
    for (; t < NT; t += 2) {
        ATT_IVAL(0, t, 1, sb0, sb1, sa0, sa1);
        ATT_IVAL(0, t + 1, 0, sa0, sa1, sb0, sb1);
    }
#undef ATT_FIVAL
#undef ATT_GLDS
#undef ATT_DMAK
#undef ATT_DMAV
#undef ATT_SYNC
#undef ATT_QK
#undef ATT_SB
#undef ATT_KRD
#undef ATT_KMM
#undef ATT_VRD
#undef ATT_VMM
#undef ATT_PV
#undef ATT_SOFTMAX
#undef ATT_NEED
#undef ATT_IVAL
#undef ATT_FAST
#undef ATT_MXC
#undef ATT_EXC
    l_out = l_run + __shfl_xor(l_run, 32);
}
}

constexpr int LDS_BYTES = 147456, MISC_OFF = 131072 + 8192;
typedef unsigned short bf16_t;
typedef float f32x4 __attribute__((ext_vector_type(4)));
typedef unsigned u32x4 __attribute__((ext_vector_type(4)));
typedef unsigned u32x2 __attribute__((ext_vector_type(2)));

struct Args { const void* in[27]; float* out; unsigned char* ws; unsigned long long use_cg; };

__device__ __forceinline__ float wave_sum(float v) {
#pragma unroll
    for (int o = 1; o < 64; o <<= 1) v += __shfl_xor(v, o);
    return v;
}
__device__ __forceinline__ unsigned f2bf(float f) { unsigned u = __builtin_bit_cast(unsigned, f); return (u + 0x7fffu + ((u >> 16) & 1u)) >> 16; }
__device__ __forceinline__ unsigned pk2(float lo, float hi) { return f2bf(lo) | (f2bf(hi) << 16); }

enum { WK_GU = 0, WK_PLAIN = 1, WK_IN = 2, WK_UQ = 3, WK_UKV = 4, WK_OUT = 5 };
template <int KIND>
__device__ __forceinline__ void transpose_item(const float* W, const float* W2, const float* ks1, const float* ks2, int K, int Nsrc, int Ndst, bf16_t* WT, LAS float* scr, int item, int lane) {
    const int nblk = Ndst / 32, kb = item / nblk, nb = item % nblk, k0 = 64 * kb, n0 = 32 * nb;
    const int np = n0 + (lane & 31);
    const float* src = W; int sc = np; bool valid = true;
    if (KIND == WK_GU) { const int tile = np >> 8, p = np & 255; src = (p >> 7) ? W2 : W; sc = tile * 128 + (p & 127); }
    else if (KIND == WK_IN) { const int tile = np >> 8, p = np & 255, bj = p >> 7, wc = (p & 127) >> 5, j = p & 31;
        if (tile < 4) sc = 256 * tile + 64 * wc + 32 * bj + j;
        else if (tile < 6) sc = 256 * tile + p;
        else if (tile == 6) sc = 1536 + p;
        else if (tile == 7) { if (bj == 0) sc = 1792 + p; else if (wc == 0) sc = 2176 + 16 * ((j >> 2) & 1) + 4 * (j >> 3) + (j & 3); else valid = false; }
        else sc = 1920 + p; }
    else if (KIND == WK_UQ) { const int tile = np >> 8, p = np & 255, bj = p >> 7, wc = (p & 127) >> 5, j = p & 31;
        if (bj == 0) sc = (2 * tile + (wc >> 1)) * 96 + 32 * (wc & 1) + j;
        else if (wc < 2) sc = (2 * tile + wc) * 96 + 64 + 16 * ((j >> 2) & 1) + 4 * (j >> 3) + (j & 3);
        else valid = false; }
    else if (KIND == WK_UKV) { if (np < 256) sc = (np >> 6) * 192 + (np & 63); else { const int q = np - 256; sc = (q >> 7) * 192 + 64 + (q & 127); } }
    float vv[32];
#pragma unroll
    for (int i = 0; i < 32; ++i) { const int k = k0 + 2 * i + (lane >> 5); const int ksrc = (KIND == WK_OUT) ? ((k + 512) & 1023) : k; vv[i] = valid ? src[(size_t)ksrc * Nsrc + sc] : 0.f; }
#pragma unroll
    for (int i = 0; i < 32; ++i) { const int kk = 2 * i + (lane >> 5), k = k0 + kk; float v = vv[i];
        if (KIND == WK_UQ || KIND == WK_UKV) v *= ks1[k];
        if (KIND == WK_OUT) v *= (k < 512) ? ks2[k] : ks1[(k - 512) & 127] * 0.8f;
        scr[kk * 33 + (lane & 31)] = v; }
    asm volatile("s_waitcnt lgkmcnt(0)" ::: "memory");
    const int c = lane & 7;
#pragma unroll
    for (int j = 0; j < 4; ++j) { const int n = (lane >> 3) + 8 * j; const LAS float* s = scr + (8 * c) * 33 + n;
        u32x4 o; o.x = pk2(s[0 * 33], s[1 * 33]); o.y = pk2(s[2 * 33], s[3 * 33]); o.z = pk2(s[4 * 33], s[5 * 33]); o.w = pk2(s[6 * 33], s[7 * 33]);
        *(u32x4*)(WT + (size_t)(n0 + n) * K + k0 + 8 * c) = o; }
    asm volatile("s_waitcnt lgkmcnt(0)" ::: "memory");
}

__device__ __forceinline__ void norm_mod_pass(const float* h, bf16_t* u, const float* modf, int slot_sh, int gw, int NGW, int lane, int nrows) {
    for (int row = gw; row < nrows; row += 2 * NGW) {
        const int row2 = row + NGW; const bool has2 = row2 < nrows;
        const f32x4* hr0 = (const f32x4*)(h + (size_t)row * DM) + lane; const f32x4* hr1 = (const f32x4*)(h + (size_t)(has2 ? row2 : row) * DM) + lane;
        f32x4 v0[4], v1[4]; float s0 = 0.f, s1 = 0.f;
#pragma unroll
        for (int j = 0; j < 4; ++j) { v0[j] = hr0[64 * j]; v1[j] = hr1[64 * j]; }
#pragma unroll
        for (int j = 0; j < 4; ++j) { s0 += (v0[j][0] * v0[j][0] + v0[j][1] * v0[j][1]) + (v0[j][2] * v0[j][2] + v0[j][3] * v0[j][3]); s1 += (v1[j][0] * v1[j][0] + v1[j][1] * v1[j][1]) + (v1[j][2] * v1[j][2] + v1[j][3] * v1[j][3]); }
        const float r0 = __builtin_amdgcn_rsqf(wave_sum(s0) * (1.f / DM) + NORM_EPS), r1 = __builtin_amdgcn_rsqf(wave_sum(s1) * (1.f / DM) + NORM_EPS);
#pragma unroll
        for (int q = 0; q < 2; ++q) { if (q == 1 && !has2) break;
            const int rw = q ? row2 : row; const int b = rw >> 11; const float rstd = q ? r1 : r0;
            const f32x4* ar = (const f32x4*)(modf + (size_t)b * NMOD + (slot_sh + 1) * DM) + lane;
            const f32x4* sr = (const f32x4*)(modf + (size_t)b * NMOD + slot_sh * DM) + lane;
            unsigned long long* o8 = (unsigned long long*)(u + (size_t)rw * DM) + lane;
#pragma unroll
            for (int j = 0; j < 4; ++j) { const f32x4 a = ar[64 * j], sh = sr[64 * j]; const f32x4 y = (q ? v1[j] : v0[j]) * rstd * a + sh;
                o8[64 * j] = (unsigned long long)pk2(y[0], y[1]) | ((unsigned long long)pk2(y[2], y[3]) << 32); } }
    }
}

#define XB_TMO      128
#define XB_XCNT(j)  (256  + 64 * (j))
#define XB_XSUB(j)  (1280 + 64 * (j))
#define XB_XGEN(j)  (2304 + 64 * (j))
#define XB_TOP      3328
#define XB_TOPGEN   3392
#define XCD_BAR_WORDS 3456
#define XB_SPIN_CAP (1u << 18)

__device__ __forceinline__ unsigned xb_ld(unsigned* p)              { return __hip_atomic_load(p, __ATOMIC_RELAXED, __HIP_MEMORY_SCOPE_AGENT); }
__device__ __forceinline__ unsigned xb_add(unsigned* p, unsigned v) { return __hip_atomic_fetch_add(p, v, __ATOMIC_RELAXED, __HIP_MEMORY_SCOPE_AGENT); }
__device__ __forceinline__ unsigned xb_xcc_id() { return (unsigned)__builtin_amdgcn_s_getreg((3 << 11) | 20) & 0xFu; }
#define XB_SPIN(cond, bar) do { unsigned _sp = 0; while (cond) { __builtin_amdgcn_s_sleep(1); \
    if ((++_sp & 255u) == 0u) { if (xb_ld(&(bar)[XB_TMO])) break; if (_sp > XB_SPIN_CAP) { atomicAdd(&(bar)[XB_TMO], 1u); break; } } } } while (0)

struct XcdBarrier {
    unsigned* bar; unsigned x; unsigned G;
    volatile LAS unsigned* st;
};

__device__ __forceinline__ XcdBarrier xcd_barrier_post(unsigned* bar, volatile LAS unsigned* st, const bool leader, const unsigned G) {
    XcdBarrier b; b.bar = bar; b.x = xb_xcc_id(); b.st = st; b.G = G;
    if (leader) (void)xb_add(&bar[XB_XCNT(b.x)], 1u);
    return b;
}
__device__ __forceinline__ void xcd_barrier_complete(unsigned* bar, unsigned x, const unsigned G, unsigned& nloc, unsigned& nx) {
    unsigned sum, cnt, mine, sp = 0u;
    for (;;) {
        sum = 0u; cnt = 0u; mine = 0u;
#pragma unroll
        for (unsigned j = 0; j < 16; ++j) { const unsigned c = xb_ld(&bar[XB_XCNT(j)]); sum += c; cnt += (c > 0u) ? 1u : 0u; mine = (j == x) ? c : mine; }
        if (sum == G) break;
        __builtin_amdgcn_s_sleep(1);
        if ((++sp & 255u) == 0u) { if (xb_ld(&bar[XB_TMO])) break; if (sp > XB_SPIN_CAP) { atomicAdd(&bar[XB_TMO], 1u); break; } }
    }
    nloc = mine > 0u ? mine : 1u; nx = cnt > 0u ? cnt : 1u;
}

__device__ __forceinline__ void xcd_barrier(const XcdBarrier& b, const bool leader) {
    asm volatile("s_waitcnt vmcnt(0)" ::: "memory");
    __syncthreads();
    if (leader) {
        unsigned* bar = b.bar;
        __builtin_amdgcn_s_waitcnt(0);
        unsigned nloc = b.st[0], nx = b.st[1];
        if (nloc == 0u) { xcd_barrier_complete(bar, b.x, b.G, nloc, nx); b.st[0] = nloc; b.st[1] = nx; }
        const unsigned old = xb_add(&bar[XB_XSUB(b.x)], 1u);
        const unsigned gen = old / nloc;
        if (old + 1u == (gen + 1u) * nloc) {
            __builtin_amdgcn_fence(__ATOMIC_RELEASE, "agent");
            asm volatile("s_waitcnt vmcnt(0)" ::: "memory");
            if (nx > 1u) {
            const unsigned og = xb_add(&bar[XB_TOP], 1u);
            const unsigned tg = og / nx;
            if (og + 1u == (tg + 1u) * nx) xb_add(&bar[XB_TOPGEN], 1u);
            else XB_SPIN(xb_ld(&bar[XB_TOPGEN]) == tg, bar);
            }
            __builtin_amdgcn_fence(__ATOMIC_ACQUIRE, "agent");
            xb_add(&bar[XB_XGEN(b.x)], 1u);
            asm volatile("s_waitcnt vmcnt(0)" ::: "memory");
        } else {
            XB_SPIN(xb_ld(&bar[XB_XGEN(b.x)]) == gen, bar);
            __builtin_amdgcn_fence(__ATOMIC_ACQUIRE, "agent");
            asm volatile("s_waitcnt vmcnt(0)" ::: "memory");
        }
    }
    __syncthreads();
}

template <class Epi>
__device__ __forceinline__ void run_gemm(LAS unsigned char* lds, const bf16_t* A, const bf16_t* Bt, int N, int K, const Epi& E, const int tid) {
    pg8::Gemm g{A, Bt, M, N, K}; pg8::StaticOrder S; S.init(M, N, (int)gridDim.x, (int)blockIdx.x);
    pg8::gemm_phase<Epi, pg8::StaticOrder, true, GEMM_SP2>(lds, g, S, E, tid);
}

__global__ void __launch_bounds__(512) hymba_fwd(Args args) {
    extern __shared__ __attribute__((aligned(16))) unsigned char lds_raw[];
    LAS unsigned char* lds = (LAS unsigned char*)lds_raw;
    cg::grid_group grid = cg::this_grid();
    const int wid = __builtin_amdgcn_readfirstlane(threadIdx.x >> 6);
#define TID() ((wid << 6) | lane_id())
    const int G = gridDim.x, gw = blockIdx.x * 8 + wid, NGW = G * 8;
    { const int tid = TID(); volatile LAS unsigned* MISC0 = (volatile LAS unsigned*)(lds + MISC_OFF); if (tid < 32) MISC0[tid] = 0u; }
    unsigned char* ws = args.ws;
    volatile LAS unsigned* MISC = (volatile LAS unsigned*)(lds + MISC_OFF);
    __syncthreads();
    const int NISL = (G == 256) ? 8 : 1, isl = (int)blockIdx.x % NISL, GI = G / NISL, jblk = (int)blockIdx.x / NISL;
    const XcdBarrier xbar = xcd_barrier_post((unsigned*)(ws + WS_CTL) + 2048, MISC + 8, TID() == 0, (unsigned)G);
    const XcdBarrier ibar = xcd_barrier_post((unsigned*)(ws + WS_CTL) + 32768 + 4096 * isl, MISC + 10, TID() == 0, (unsigned)GI);
#define GSYNC_ALL() xcd_barrier(xbar, TID() == 0)
#define GSYNC() xcd_barrier(ibar, TID() == 0)
    const float* x = (const float*)args.in[0];
    float* out = args.out;
    float* modf = (float*)(ws + WS_MODF);
    float* COSD = (float*)(ws + WS_COSD); float* SIND = (float*)(ws + WS_SIND); float* COSR = (float*)(ws + WS_COSR); float* SINR = (float*)(ws + WS_SINR);
    float* SSCQ = (float*)(ws + WS_SSCQ); float* SSCKV = (float*)(ws + WS_SSCKV); float* SSOM = (float*)(ws + WS_SSOM);
    bf16_t* WGU1 = (bf16_t*)(ws + WS_WGU1); bf16_t* WD1 = (bf16_t*)(ws + WS_WD1); bf16_t* WGU2 = (bf16_t*)(ws + WS_WGU2); bf16_t* WD2 = (bf16_t*)(ws + WS_WD2);
    bf16_t* WIN = (bf16_t*)(ws + WS_WIN); bf16_t* WOUT = (bf16_t*)(ws + WS_WOUT); bf16_t* WUQ = (bf16_t*)(ws + WS_WUQ); bf16_t* WUKV = (bf16_t*)(ws + WS_WUKV);
    bf16_t* U = (bf16_t*)(ws + WS_U); bf16_t* HID = (bf16_t*)(ws + WS_HID);
    bf16_t* DQ = (bf16_t*)(ws + WS_DQ); bf16_t* DK = (bf16_t*)(ws + WS_DK); bf16_t* DV = (bf16_t*)(ws + WS_DV); bf16_t* CQ = (bf16_t*)(ws + WS_CQ); bf16_t* CKV = (bf16_t*)(ws + WS_CKV);
    bf16_t* KR = (bf16_t*)(ws + WS_KR); bf16_t* MQ = (bf16_t*)(ws + WS_MQ); bf16_t* MK = (bf16_t*)(ws + WS_MK); bf16_t* MV = (bf16_t*)(ws + WS_MV);
    bf16_t* ATT = U; bf16_t* U3 = (bf16_t*)(ws + WS_U3); bf16_t* HB = (bf16_t*)(ws + WS_HB);

    for (int rep0 = 0; rep0 < REP_P0; ++rep0) {
        const int tid = TID(), lane = tid & 63;
        if (REP_P0 > 1) __syncthreads();
        if (blockIdx.x < 144) {
            const float* c = (const float*)args.in[1]; const float* w_ada = (const float*)args.in[3]; const float* b_ada = (const float*)args.in[4];
            LAS float* cs = (LAS float*)lds; LAS float* red = (LAS float*)(lds + 65536);
            for (int i = tid; i < BATCH * DM; i += 512) { const float v = c[i]; cs[i] = v / (1.f + __expf(-v)); }
            __syncthreads();
            const int col = blockIdx.x * 64 + lane;
            float acc[16];
#pragma unroll
            for (int b = 0; b < 16; ++b) acc[b] = 0.f;
            const float* wp = w_ada + (size_t)(wid * 128) * NMOD + col;
            for (int k0 = 0; k0 < 128; k0 += 16) {
                float w[16];
#pragma unroll
                for (int j = 0; j < 16; ++j) w[j] = wp[(size_t)(k0 + j) * NMOD];
#pragma unroll
                for (int j = 0; j < 16; ++j)
#pragma unroll
                    for (int b = 0; b < 16; ++b) acc[b] += cs[b * DM + wid * 128 + k0 + j] * w[j];
            }
#pragma unroll
            for (int b = 0; b < 16; ++b) red[(wid * 16 + b) * 64 + lane] = acc[b];
            __syncthreads();
            const int slot = (blockIdx.x * 64) >> 10;
            const float* gn = (slot == 1) ? (const float*)args.in[5] : (slot == 4) ? (const float*)args.in[9] : (const float*)args.in[22];
#pragma unroll
            for (int h = 0; h < 2; ++h) { const int b = (tid >> 6) + 8 * h; float s = 0.f;
#pragma unroll
                for (int w = 0; w < 8; ++w) s += red[(w * 16 + b) * 64 + lane];
                s += b_ada[col];
                if (slot == 1 || slot == 4 || slot == 7) s = gn[col & 1023] * (1.f + s);
                if (slot == 2 || slot == 8) s *= 0.5f;
                modf[(size_t)b * NMOD + col] = s; }
            __syncthreads();
        }
        if (blockIdx.x == 255 && tid == 0) {
            const float* q1 = (const float*)args.in[11]; const float* k1 = (const float*)args.in[12]; const float* q2 = (const float*)args.in[13]; const float* k2 = (const float*)args.in[14];
            float s1 = 0.f, s2 = 0.f;
            for (int i = 0; i < 64; ++i) { s1 += q1[i] * k1[i]; s2 += q2[i] * k2[i]; }
            *(float*)(ws + WS_LAM) = __expf(s1) - __expf(s2) + 0.2f;
        }
        { const int* pos = (const int*)args.in[2];
          const int gt = blockIdx.x * 512 + tid, NGT = G * 512;
          for (int i = gt; i < M * 32; i += NGT) { const int row = i >> 5, j = i & 31;
              const float inv = exp2f(-(float)(2 * j) * (13.287712379549449f / 64.f)); const float ang = (float)pos[row] * inv;
              const double rv = (double)ang * 0.15915494309189535; const float fr = (float)(rv - __builtin_rint(rv));
              COSD[i] = __builtin_amdgcn_cosf(fr); SIND[i] = __builtin_amdgcn_sinf(fr); }
          for (int i = gt; i < M * 16; i += NGT) { const int row = i >> 4, j = i & 15;
              const float inv = exp2f(-(float)(2 * j) * (13.287712379549449f / 32.f)); const float ang = (float)pos[row] * inv;
              const double rv = (double)ang * 0.15915494309189535; const float fr = (float)(rv - __builtin_rint(rv));
              COSR[i] = __builtin_amdgcn_cosf(fr); SINR[i] = __builtin_amdgcn_sinf(fr); } }
        { LAS float* scr = (LAS float*)(lds + wid * 16384);
          constexpr int I_GU = 16 * 176, I_D = 44 * 32, I_IN = 16 * 72, I_OUT = 16 * 32, I_UQ = 6 * 16, I_UKV = 4 * 24;
          constexpr int NITEMS = 2 * (I_GU + I_D) + I_IN + I_OUT + I_UQ + I_UKV;
          const int gwr = ((blockIdx.x + 112) & 255) * 8 + wid;
          for (int it = gwr; it < NITEMS; it += NGW) {
              int r = it;
              if (r < I_GU) { transpose_item<WK_GU>((const float*)args.in[6], (const float*)args.in[7], nullptr, nullptr, DM, DFF, 2 * DFF, WGU1, scr, r, lane); continue; } r -= I_GU;
              if (r < I_GU) { transpose_item<WK_GU>((const float*)args.in[23], (const float*)args.in[24], nullptr, nullptr, DM, DFF, 2 * DFF, WGU2, scr, r, lane); continue; } r -= I_GU;
              if (r < I_D) { transpose_item<WK_PLAIN>((const float*)args.in[8], nullptr, nullptr, nullptr, DFF, DM, DM, WD1, scr, r, lane); continue; } r -= I_D;
              if (r < I_D) { transpose_item<WK_PLAIN>((const float*)args.in[25], nullptr, nullptr, nullptr, DFF, DM, DM, WD2, scr, r, lane); continue; } r -= I_D;
              if (r < I_IN) { transpose_item<WK_IN>((const float*)args.in[10], nullptr, nullptr, nullptr, DM, 2208, 2304, WIN, scr, r, lane); continue; } r -= I_IN;
              if (r < I_OUT) { transpose_item<WK_OUT>((const float*)args.in[21], nullptr, (const float*)args.in[15], (const float*)args.in[20], DM, DM, DM, WOUT, scr, r, lane); continue; } r -= I_OUT;
              if (r < I_UQ) { transpose_item<WK_UQ>((const float*)args.in[17], nullptr, (const float*)args.in[16], nullptr, 384, 384, 512, WUQ, scr, r, lane); continue; } r -= I_UQ;
              transpose_item<WK_UKV>((const float*)args.in[19], nullptr, (const float*)args.in[18], nullptr, 256, 768, 768, WUKV, scr, r, lane);
          } }
    }
    if (args.use_cg) grid.sync(); else GSYNC_ALL();
    { const int rows_i = M / NISL; norm_mod_pass(x + (size_t)isl * rows_i * DM, U + (size_t)isl * rows_i * DM, modf + (size_t)(isl * (BATCH / NISL)) * NMOD, 0, jblk * 8 + wid, GI * 8, lane_id(), rows_i); }
    {
        const int lane = lane_id();
        float* CV1 = (float*)(ws + WS_CV1); float* CV2 = (float*)(ws + WS_CV2);
        const int nstep = GI * 8;
        for (int n0 = jblk * 8 + wid; n0 < 2304 + 2 * DFF; n0 += 4 * nstep) {
            u32x4 w0[4], w1[4];
#pragma unroll
            for (int q = 0; q < 4; ++q) { const int n = n0 + q * nstep, nn = (n < 2304 + 2 * DFF) ? n : n0; const bf16_t* wrow = (nn < 2304) ? (WIN + (size_t)nn * DM) : (WGU2 + (size_t)(nn - 2304) * DM);
                w0[q] = *(const u32x4*)(wrow + lane * 16); w1[q] = *(const u32x4*)(wrow + lane * 16 + 8); }
#pragma unroll
            for (int q = 0; q < 4; ++q) { const int n = n0 + q * nstep; if (n >= 2304 + 2 * DFF) break;
                const bool first = n < 2304; const int slot = first ? 3 : 6;
                float wf[16];
#pragma unroll
                for (int j = 0; j < 4; ++j) { wf[2 * j] = __uint_as_float(w0[q][j] << 16); wf[2 * j + 1] = __uint_as_float(w0[q][j] & 0xffff0000u); wf[8 + 2 * j] = __uint_as_float(w1[q][j] << 16); wf[9 + 2 * j] = __uint_as_float(w1[q][j] & 0xffff0000u); }
                for (int b = isl * (BATCH / NISL); b < (isl + 1) * (BATCH / NISL); ++b) {
                    const f32x4* sp = (const f32x4*)(modf + (size_t)b * NMOD + slot * DM + lane * 16);
                    float p = 0.f;
#pragma unroll
                    for (int j = 0; j < 4; ++j) { const f32x4 a = sp[j]; p += (a[0] * wf[4 * j] + a[1] * wf[4 * j + 1]) + (a[2] * wf[4 * j + 2] + a[3] * wf[4 * j + 3]); }
                    p = wave_sum(p);
                    if (lane == 0) { if (first) CV1[(size_t)b * 2304 + n] = p; else CV2[(size_t)b * (2 * DFF) + (n - 2304)] = p; }
                }
            }
        }
    }
    GSYNC();
    for (int rep = 0; rep < EXTRA_SYNC; ++rep) grid.sync();
#ifndef NO_SWI1
    for (int rep = 0; rep < REP_P2; ++rep) { pg8::EpiSwiGLU<false> E{HID, DFF, nullptr, nullptr}; run_gemm(lds, U, WGU1, 2 * DFF, DM, E, TID()); }
#endif
    GSYNC();
#ifndef NO_RES1
    for (int rep = 0; rep < REP_P3; ++rep) { pg8::EpiResidNorm<0, 0, 1> E{x, HB, modf, 2, 3, U, nullptr, (float*)(ws + WS_XBUF), (unsigned*)(ws + WS_PCNT), 32u * (unsigned)(rep + 1), lds + 131072, nullptr}; run_gemm(lds, HID, WD1, DM, DFF, E, TID()); }
#endif
    GSYNC();
#ifndef NO_PROJ
    for (int rep = 0; rep < REP_P5; ++rep) { pg8::EpiProj E{ws}; run_gemm(lds, U, WIN, 2304, DM, E, TID()); }
#endif
    GSYNC();
#ifndef NO_UQ
    for (int rep6 = 0; rep6 < REP_P6; ++rep6) { pg8::EpiUq E{ws}; run_gemm(lds, CQ, WUQ, 512, 384, E, TID()); }
#endif
#ifndef NO_UKV
    for (int rep6 = 0; rep6 < REP_P6; ++rep6) { pg8::EpiUkv E{ws}; run_gemm(lds, CKV, WUKV, 768, 256, E, TID()); }
#endif
    GSYNC();
#ifndef NO_ATT
    {
        unsigned* ctr = (unsigned*)(ws + WS_CTL) + 16 + 64 * isl;
        const int upc = 64 / NISL;
        const float lam = *(const float*)(ws + WS_LAM);
        for (;;) {
            int tid_a = TID(); asm volatile("" : "+v"(tid_a));
            const int tid = tid_a, lane = tid & 63;
            const int r32 = lane & 31, hi = lane >> 5;
            unsigned mo_ = MISC_OFF; asm volatile("" : "+s"(mo_));
            volatile LAS unsigned* misc = (volatile LAS unsigned*)(lds + mo_);
            if (tid == 0) misc[0] = atomicAdd(ctr, 1u);
            __syncthreads();
            const unsigned ui = misc[0];
            __syncthreads();
            if (ui >= (unsigned)(16 * upc) * REP_ATT) break;
            const unsigned long long order = 0x7654FE3D2CB1A908ull;
            const int uu = (int)(ui % (unsigned)(16 * upc)), cls = uu / upc, rem = uu % upc, code = (int)((order >> (4 * (15 - cls))) & 15ull);
            const int mla = code >> 3, qb = code & 7, b = isl * (BATCH / NISL) + (rem >> 2), h = rem & 3;
            const int q0 = qb * 256; const size_t rb = (size_t)b * SEQ;
            att::f32x16 o[4]; float l;
            const int myrow = q0 + wid * 32 + r32;
            bf16_t* orow = ATT + (rb + myrow) * DM + (mla ? 0 : 512) + h * 128 + 4 * hi;
#ifdef T_NOMLA
            if (false) {
#elif defined(T_NODIFF)
            if (true) {
#else
            if (mla) {
#endif
                att::PassArgs pa{MQ + rb * 384 + h * 96, 384, MK + rb * 256 + h * 64, 256, KR + rb * 32, 32, MV + rb * 512 + h * 128, 512};
                att::flash_pass<96>(o, l, pa, q0, lds, tid, wid, lane);
                const float il = 1.f / l; float ss = 0.f;
#pragma unroll
                for (int db = 0; db < 4; ++db)
#pragma unroll
                    for (int r = 0; r < 16; ++r) { o[db][r] *= il; ss += o[db][r] * o[db][r]; }
                ss += __shfl_xor(ss, 32);
                if (hi == 0) SSOM[(rb + myrow) * 4 + h] = ss;
#pragma unroll
                for (int db = 0; db < 4; ++db)
#pragma unroll
                    for (int g = 0; g < 4; ++g) { u32x2 w; w.x = att::cvtpk(o[db][4 * g], o[db][4 * g + 1]); w.y = att::cvtpk(o[db][4 * g + 2], o[db][4 * g + 3]); *(u32x2*)(orow + 32 * db + 8 * g) = w; }
            } else {
                LAS unsigned* oast = (LAS unsigned*)(lds + 61440) + wid * 2048 + lane;
                for (int mp = 0; mp < 2; ++mp) {
                    att::PassArgs pa{DQ + rb * 512 + (2 * h + mp) * 64, 512, DK + rb * 512 + (2 * h + mp) * 64, 512, nullptr, 0, DV + rb * 512 + h * 128, 512};
                    att::flash_pass<64>(o, l, pa, q0, lds, tid, wid, lane);
                    const float il = 1.f / l;
                    if (mp == 0) {
#pragma unroll
                        for (int db = 0; db < 4; ++db)
#pragma unroll
                            for (int j = 0; j < 8; ++j) oast[(db * 8 + j) * 64] = att::cvtpk(o[db][2 * j] * il, o[db][2 * j + 1] * il);
                    } else {
                        float ss = 0.f; const float c2 = lam * il;
#pragma unroll
                        for (int db = 0; db < 4; ++db)
#pragma unroll
                            for (int j = 0; j < 8; ++j) { const unsigned w = oast[(db * 8 + j) * 64]; const float a0 = __uint_as_float(w << 16), a1 = __uint_as_float(w & 0xffff0000u);
                                const float d0 = a0 - c2 * o[db][2 * j], d1 = a1 - c2 * o[db][2 * j + 1]; o[db][2 * j] = d0; o[db][2 * j + 1] = d1; ss += d0 * d0 + d1 * d1; }
                        ss += __shfl_xor(ss, 32);
                        const float rstd = __builtin_amdgcn_rsqf(ss * (1.f / 128.f) + NORM_EPS);
#pragma unroll
                        for (int db = 0; db < 4; ++db)
#pragma unroll
                            for (int g = 0; g < 4; ++g) { u32x2 w; w.x = att::cvtpk(o[db][4 * g] * rstd, o[db][4 * g + 1] * rstd); w.y = att::cvtpk(o[db][4 * g + 2] * rstd, o[db][4 * g + 3] * rstd); *(u32x2*)(orow + 32 * db + 8 * g) = w; }
                    }
                }
            }
        }
    }
#endif
    GSYNC();
#ifndef NO_RES2
    { pg8::EpiResidNorm<0, 1, 1, true> E{HB, HB, modf, 5, 6, U3, nullptr, (float*)(ws + WS_XBUF), (unsigned*)(ws + WS_PCNT), 32u * REP_P3 + 32u, lds + 131072, SSOM}; run_gemm(lds, ATT, WOUT, DM, DM, E, TID()); }
#endif
    GSYNC();
#ifndef NO_SWI2
    { pg8::EpiSwiGLU<true> E{HID, DFF, (const float*)(ws + WS_XBUF), (const float*)(ws + WS_CV2)}; run_gemm(lds, U3, WGU2, 2 * DFF, DM, E, TID()); }
#endif
    GSYNC();
#ifndef NO_RES3
    { pg8::EpiResidNorm<1, 1, 0> E{HB, out, modf, 8, 0, nullptr, (const float*)args.in[26], (float*)(ws + WS_XBUF), (unsigned*)(ws + WS_PCNT), 32u, lds + 131072, nullptr}; run_gemm(lds, HID, WD2, DM, DFF, E, TID()); }
#endif
}

extern "C" void kernel_launch(void* const* d_in, const int* in_sizes, int n_in, void* d_out, int out_size, void* d_ws, size_t ws_size, hipStream_t stream) {
    static int grid_blocks = 0;
    if (grid_blocks == 0) {
        if (n_in != 27 || out_size != M * DM || ws_size < WS_END) { fprintf(stderr, "kernel_launch: unexpected shapes (n_in %d, out %d, ws %zu)\n", n_in, out_size, ws_size); grid_blocks = -1; return; }
        int dev = 0, cus = 0, per_cu = 0;
        hipGetDevice(&dev);
        hipDeviceGetAttribute(&cus, hipDeviceAttributeMultiprocessorCount, dev);
        if (hipFuncSetAttribute((const void*)hymba_fwd, hipFuncAttributeMaxDynamicSharedMemorySize, LDS_BYTES) != hipSuccess) { fprintf(stderr, "kernel_launch: hipFuncSetAttribute failed\n"); grid_blocks = -1; return; }
        if (hipOccupancyMaxActiveBlocksPerMultiprocessor(&per_cu, (const void*)hymba_fwd, 512, LDS_BYTES) != hipSuccess || per_cu < 1) { fprintf(stderr, "kernel_launch: occupancy query failed (%d)\n", per_cu); (void)hipGetLastError(); per_cu = 1; }
        grid_blocks = cus * per_cu;
    }
    if (grid_blocks < 0) return;
    (void)hipMemsetAsync((char*)d_ws + WS_CTL, 0, 262144, stream);
    Args a{};
    for (int i = 0; i < 27; ++i) a.in[i] = d_in[i];
    a.out = (float*)d_out; a.ws = (unsigned char*)d_ws; a.use_cg = 0ull;
    void* kargs[] = {&a};
    hipError_t e = hipLaunchCooperativeKernel((const void*)hymba_fwd, dim3(grid_blocks), dim3(512), kargs, LDS_BYTES, stream);
    if (e != hipSuccess) fprintf(stderr, "cooperative launch failed: %s (grid %d)\n", hipGetErrorString(e), grid_blocks);
}
```
